# Optimizing an MI355X kernel written in HIP

```python
import jax, jax.numpy as jnp
from jax import lax
import numpy as np

D_MODEL = 1024
BATCH = 2
SEQ = 8192
DEPTH = 2

CHUNK = 64
N_A_LAYERS = max(1, DEPTH // 2)
N_B_LAYERS = DEPTH - N_A_LAYERS
A_HEADS = 16
A_HEAD_DIM = D_MODEL // A_HEADS
A_LEFT_CHUNKS = 8
A_BAND = (A_LEFT_CHUNKS + 1) * CHUNK
A_MAX_REL = 2 * CHUNK
B_HEADS = 16
B_NOPE_DIM = 64
B_ROPE_DIM = 32
B_V_DIM = 64
B_Q_LORA = 384
B_KV_LORA = 256
ROPE_THETA = 10000.0
Q_BLOCK = 128
FFN_DIM = 2816
CONV_WIDTH = 3
NORM_EPS = 1e-6
NEG_INF = -1e30

kernel_name = "yoco_chunkrel_mla_convffn_adaln"


def rms_norm(x, g):
    xf = x.astype(jnp.float32)
    y = xf * lax.rsqrt(jnp.mean(xf * xf, axis=-1, keepdims=True) + NORM_EPS)
    return (y * g.astype(jnp.float32)).astype(x.dtype)


def modulate(x, shift, scale):
    return x * (1.0 + scale[:, None, :]) + shift[:, None, :]


def rope_tables(positions):
    half = B_ROPE_DIM // 2
    inv_freq = jnp.power(jnp.float32(ROPE_THETA),
                         -jnp.arange(half, dtype=jnp.float32) * (2.0 / B_ROPE_DIM))
    ang = positions.astype(jnp.float32)[..., None] * inv_freq
    return jnp.cos(ang), jnp.sin(ang)


def apply_rope(t, cos, sin):
    half = t.shape[-1] // 2
    tf = t.astype(jnp.float32)
    t1, t2 = tf[..., :half], tf[..., half:]
    return jnp.concatenate([t1 * cos - t2 * sin, t2 * cos + t1 * sin], axis=-1).astype(t.dtype)


def chunk_rel_attention(hn, wqkv, wo, rel_bias):
    B, S, _ = hn.shape
    nc = S // CHUNK
    qkv = (hn @ wqkv).reshape(B, S, 3, A_HEADS, A_HEAD_DIM)
    q, k, v = qkv[:, :, 0], qkv[:, :, 1], qkv[:, :, 2]
    pad = A_LEFT_CHUNKS * CHUNK
    kp = jnp.pad(k, ((0, 0), (pad, 0), (0, 0), (0, 0)))
    vp = jnp.pad(v, ((0, 0), (pad, 0), (0, 0), (0, 0)))
    qi = jnp.arange(CHUNK)[:, None]
    kj = jnp.arange(A_BAND)[None, :]
    rel = jnp.clip(qi + pad - kj, -A_MAX_REL, A_MAX_REL) + A_MAX_REL
    bias = rel_bias.astype(jnp.float32)[:, rel]
    scale = A_HEAD_DIM ** -0.5
    band_idx = jnp.arange(A_BAND)

    def one_chunk(n):
        start = n * CHUNK
        qc = lax.dynamic_slice_in_dim(q, start, CHUNK, axis=1)
        kc = lax.dynamic_slice_in_dim(kp, start, A_BAND, axis=1)
        vc = lax.dynamic_slice_in_dim(vp, start, A_BAND, axis=1)
        s = jnp.einsum('bqhd,bkhd->bhqk', qc, kc).astype(jnp.float32) * scale + bias[None]
        valid = (start - pad + band_idx) >= 0
        s = jnp.where(valid[None, None, None, :], s, NEG_INF)
        p = jax.nn.softmax(s, axis=-1).astype(vc.dtype)
        return jnp.einsum('bhqk,bkhd->bqhd', p, vc)

    o = lax.map(one_chunk, jnp.arange(nc))
    o = jnp.moveaxis(o, 0, 1).reshape(B, S, A_HEADS * A_HEAD_DIM)
    return o @ wo


def shared_kv(h, c_act, kv_mod_w, kv_mod_b, kv_norm_g, wdkv, kv_lat_norm_g, wuk, wuv, wkr, cos, sin):
    B, S, _ = h.shape
    shift, scale = jnp.split(c_act @ kv_mod_w + kv_mod_b, 2, axis=-1)
    hn = modulate(rms_norm(h, kv_norm_g), shift, scale)
    ckv = rms_norm(hn @ wdkv, kv_lat_norm_g)
    k_nope = (ckv @ wuk).reshape(B, S, B_HEADS, B_NOPE_DIM)
    v = (ckv @ wuv).reshape(B, S, B_HEADS, B_V_DIM)
    k_rope = apply_rope(hn @ wkr, cos, sin)
    return k_nope, k_rope, v


def mla_attention(hn, wdq, q_norm_g, wuq, wqr, wo, k_nope, k_rope, v, cos, sin):
    B, S, _ = hn.shape
    cq = rms_norm(hn @ wdq, q_norm_g)
    q_nope = (cq @ wuq).reshape(B, S, B_HEADS, B_NOPE_DIM)
    q_rope = apply_rope((cq @ wqr).reshape(B, S, B_HEADS, B_ROPE_DIM),
                        cos[:, :, None, :], sin[:, :, None, :])
    key_chunk = jnp.arange(S) // CHUNK
    scale = (B_NOPE_DIM + B_ROPE_DIM) ** -0.5

    def one_block(i):
        start = i * Q_BLOCK
        qn = lax.dynamic_slice_in_dim(q_nope, start, Q_BLOCK, axis=1)
        qr = lax.dynamic_slice_in_dim(q_rope, start, Q_BLOCK, axis=1)
        s = (jnp.einsum('bqhd,bkhd->bhqk', qn, k_nope).astype(jnp.float32)
             + jnp.einsum('bqhd,bkd->bhqk', qr, k_rope).astype(jnp.float32)) * scale
        q_chunk = (start + jnp.arange(Q_BLOCK)) // CHUNK
        mask = key_chunk[None, :] <= q_chunk[:, None]
        s = jnp.where(mask[None, None], s, NEG_INF)
        p = jax.nn.softmax(s, axis=-1).astype(v.dtype)
        return jnp.einsum('bhqk,bkhd->bqhd', p, v)

    o = lax.map(one_block, jnp.arange(S // Q_BLOCK))
    o = jnp.moveaxis(o, 0, 1).reshape(B, S, B_HEADS * B_V_DIM)
    return o @ wo


def conv_ffn(hn, win, conv_w, conv_b, wout):
    S = hn.shape[1]
    u = hn @ win
    up = jnp.pad(u, ((0, 0), (CONV_WIDTH - 1, 0), (0, 0)))
    y = conv_b
    for tap in range(CONV_WIDTH):
        y = y + up[:, tap:tap + S] * conv_w[tap]
    gate, val = jnp.split(y, 2, axis=-1)
    return (jax.nn.silu(gate) * val) @ wout


def setup_inputs(seed: int = 0) -> dict:
    key = jax.random.key(seed)
    ks = iter(jax.random.split(key, 40))
    D = D_MODEL

    def nrm(shape, scale):
        return jax.random.normal(next(ks), shape, jnp.float32) * scale

    def gain(shape):
        return 1.0 + nrm(shape, 0.02)

    x = nrm((BATCH, SEQ, D), 1.0)
    c = nrm((BATCH, D), 1.0)
    positions = (jnp.arange(SEQ, dtype=jnp.int32)[None, :]
                 + jax.random.randint(next(ks), (BATCH, 1), 0, 4096, dtype=jnp.int32))
    return {
        "x": x,
        "c": c,
        "positions": positions,
        "mod_w": nrm((DEPTH, D, 6 * D), 0.5 * D ** -0.5),
        "mod_b": nrm((DEPTH, 6 * D), 0.02),
        "norm1_g": gain((DEPTH, D)),
        "norm2_g": gain((DEPTH, D)),
        "a_wqkv": nrm((N_A_LAYERS, D, 3 * A_HEADS * A_HEAD_DIM), D ** -0.5),
        "a_wo": nrm((N_A_LAYERS, A_HEADS * A_HEAD_DIM, D), (A_HEADS * A_HEAD_DIM) ** -0.5),
        "a_rel_bias": nrm((N_A_LAYERS, A_HEADS, 2 * A_MAX_REL + 1), 0.5),
        "kv_mod_w": nrm((D, 2 * D), 0.5 * D ** -0.5),
        "kv_mod_b": nrm((2 * D,), 0.02),
        "kv_norm_g": gain((D,)),
        "b_wdkv": nrm((D, B_KV_LORA), D ** -0.5),
        "b_kv_lat_norm_g": gain((B_KV_LORA,)),
        "b_wuk": nrm((B_KV_LORA, B_HEADS * B_NOPE_DIM), B_KV_LORA ** -0.5),
        "b_wuv": nrm((B_KV_LORA, B_HEADS * B_V_DIM), B_KV_LORA ** -0.5),
        "b_wkr": nrm((D, B_ROPE_DIM), D ** -0.5),
        "b_wdq": nrm((N_B_LAYERS, D, B_Q_LORA), D ** -0.5),
        "b_q_norm_g": gain((N_B_LAYERS, B_Q_LORA)),
        "b_wuq": nrm((N_B_LAYERS, B_Q_LORA, B_HEADS * B_NOPE_DIM), B_Q_LORA ** -0.5),
        "b_wqr": nrm((N_B_LAYERS, B_Q_LORA, B_HEADS * B_ROPE_DIM), B_Q_LORA ** -0.5),
        "b_wo": nrm((N_B_LAYERS, B_HEADS * B_V_DIM, D), (B_HEADS * B_V_DIM) ** -0.5),
        "f_win": nrm((DEPTH, D, 2 * FFN_DIM), D ** -0.5),
        "f_conv_w": nrm((DEPTH, CONV_WIDTH, 2 * FFN_DIM), CONV_WIDTH ** -0.5),
        "f_conv_b": nrm((DEPTH, 2 * FFN_DIM), 0.02),
        "f_wout": nrm((DEPTH, FFN_DIM, D), FFN_DIM ** -0.5),
        "final_g": gain((D,)),
    }


def reference(x, c, positions, mod_w, mod_b, norm1_g, norm2_g, a_wqkv, a_wo, a_rel_bias,
              kv_mod_w, kv_mod_b, kv_norm_g, b_wdkv, b_kv_lat_norm_g, b_wuk, b_wuv, b_wkr,
              b_wdq, b_q_norm_g, b_wuq, b_wqr, b_wo, f_win, f_conv_w, f_conv_b, f_wout, final_g):
    c_act = jax.nn.silu(c)
    cos, sin = rope_tables(positions)
    h = x
    kv = None
    for l in range(DEPTH):
        mod = c_act @ mod_w[l] + mod_b[l]
        sh1, sc1, g1, sh2, sc2, g2 = jnp.split(mod, 6, axis=-1)
        hn = modulate(rms_norm(h, norm1_g[l]), sh1, sc1)
        if l < N_A_LAYERS:
            mix = chunk_rel_attention(hn, a_wqkv[l], a_wo[l], a_rel_bias[l])
        else:
            j = l - N_A_LAYERS
            mix = mla_attention(hn, b_wdq[j], b_q_norm_g[j], b_wuq[j], b_wqr[j], b_wo[j],
                                kv[0], kv[1], kv[2], cos, sin)
        h = h + g1[:, None, :] * mix
        hn = modulate(rms_norm(h, norm2_g[l]), sh2, sc2)
        h = h + g2[:, None, :] * conv_ffn(hn, f_win[l], f_conv_w[l], f_conv_b[l], f_wout[l])
        if l == N_A_LAYERS - 1:
            kv = shared_kv(h, c_act, kv_mod_w, kv_mod_b, kv_norm_g, b_wdkv, b_kv_lat_norm_g,
                           b_wuk, b_wuv, b_wkr, cos, sin)
    return rms_norm(h, final_g)
```

```cpp
#include <hip/hip_runtime.h>
#include <hip/hip_cooperative_groups.h>
#include <cstdio>
#include <cstdint>
#ifndef REP_MLA
#define REP_MLA 1
#endif
#ifndef REP_ATTA
#define REP_ATTA 1
#endif
#ifndef REP_FFNIN
#define REP_FFNIN 1
#endif
#ifndef REP_QKV
#define REP_QKV 1
#endif
#ifndef REP_P0
#define REP_P0 1
#endif
#ifndef EXTRA_SYNCS
#define EXTRA_SYNCS 0
#endif
#ifndef REP_NORM1
#define REP_NORM1 1
#endif
#ifndef REP_FFNOUT_L0
#define REP_FFNOUT_L0 0
#endif
#ifndef PH
#define PH 0xFFFF
#endif
namespace cg = cooperative_groups;

#define LAS __attribute__((address_space(3)))
typedef unsigned short bf16_t;
typedef short bf16x8 __attribute__((ext_vector_type(8)));
typedef short s16x4 __attribute__((ext_vector_type(4)));
typedef float f32x2 __attribute__((ext_vector_type(2)));
typedef float f32x4 __attribute__((ext_vector_type(4)));
typedef float f32x16 __attribute__((ext_vector_type(16)));
typedef unsigned u32x2 __attribute__((ext_vector_type(2)));
typedef unsigned u32x4 __attribute__((ext_vector_type(4)));

constexpr int BATCH = 2, SEQ = 8192, DM = 1024, T = BATCH * SEQ, FFN = 2816, FFN2 = 5632;
constexpr int NH = 16, KVL = 256, QL = 384, ROPE = 32;
constexpr int PADROWS = 8448, FT = 33;
constexpr float EPS = 1e-6f;
constexpr float LOG2E = 1.4426950408889634f;
constexpr float QS_A = 0.125f * LOG2E;
constexpr float QS_B = 0.10206207261596577f * LOG2E;

constexpr size_t MiB = 1u << 20;
constexpr size_t WS_MODV = 0;
constexpr size_t WS_SSQKV = 256 * 1024;
constexpr size_t WS_SSQQ = 512 * 1024;
constexpr size_t WS_COS = 1 * MiB, WS_SIN = 2 * MiB;
constexpr size_t WS_BAR = 3 * MiB;
constexpr size_t WS_WQKV = 4 * MiB;
constexpr size_t WS_WO = 10 * MiB;
constexpr size_t WS_WIN = 12 * MiB;
constexpr size_t WS_WOUT = 34 * MiB;
constexpr size_t WS_WLD = 45 * MiB;
constexpr size_t WS_WKVUP = 47 * MiB;
constexpr size_t WS_WQUP = 48 * MiB;
constexpr size_t WS_BWO = 50 * MiB;
constexpr size_t WS_HN = 52 * MiB;
constexpr size_t WS_R1 = 86 * MiB;
constexpr size_t WS_R2 = 118 * MiB;
constexpr size_t WS_R3 = 150 * MiB;
constexpr size_t WS_R4 = 182 * MiB;
constexpr size_t WS_ACT = 86 * MiB;
constexpr size_t WS_HN1 = 198 * MiB;
constexpr size_t WS_CKV = 230 * MiB;
constexpr size_t WS_CQ = 238 * MiB;
constexpr size_t WS_KR = 250 * MiB;
constexpr size_t WS_END = 251 * MiB;

constexpr int RING_BYTES = 131072;
constexpr int XCH_OFF = RING_BYTES;
constexpr int MISC_OFF = XCH_OFF + 8192;
constexpr int LDS_BYTES = 147456;

__device__ __forceinline__ unsigned cvt_pk_bf16(float lo, float hi) { unsigned r; asm volatile("v_cvt_pk_bf16_f32 %0, %1, %2" : "=v"(r) : "v"(lo), "v"(hi)); return r; }
__device__ __forceinline__ float lane_read(float v, int src_lane) { return __builtin_bit_cast(float, __builtin_amdgcn_ds_bpermute(src_lane << 2, __builtin_bit_cast(int, v))); }
__device__ __forceinline__ float wave_sum(float v, int lane) {
#pragma unroll
    for (int o = 1; o < 64; o <<= 1) v += lane_read(v, lane ^ o);
    return v;
}

namespace pg8 {
#define PG8_LAS __attribute__((address_space(3)))
constexpr int BM = 256, BK = 64, HALF = 128, HTB = HALF * BK * 2, STAGE_BYTES = 8 * HTB, NXCD = 8, WGM = 8;
__host__ __device__ __forceinline__ int lds_byte(int r, int c) { const int st = (r >> 4) * 2 + (c >> 5), rr = r & 15, cc = c & 31, ob = rr * 64 + cc * 2; return st * 1024 + (ob ^ (((ob >> 9) & 1) << 5)); }
__host__ __device__ __forceinline__ void stage_rc(int b, int& R, int& C) { const int st = b / 1024, sb = b % 1024, swz = sb ^ (((sb >> 9) & 1) << 5); R = (st >> 1) * 16 + swz / 64; C = (st & 1) * 32 + (swz % 64) / 2; }
__host__ __device__ __forceinline__ int perm32(int rho) { const int n = rho >> 4, i = rho & 15; return 8 * (i >> 2) + 4 * n + (i & 3); }
struct Unit { int pm, pn; };

template <int MODE> struct Sched {
    int nM, nN, nwg, G, c, K; const char* A0; const char* A1; const char* B;
    __device__ void init(int nM_, int nN_, int K_, const void* a0, const void* a1, const void* b, int G_, int c_) { nM = nM_; nN = nN_; nwg = nM * nN; K = K_; A0 = (const char*)a0; A1 = (const char*)a1; B = (const char*)b; G = G_; c = c_; }
    __device__ bool next(int i, Unit& u) const {
        const long L = (long)i * G + c; if (L >= nwg) return false;
        int wgid = (int)L; { const int q = nwg / NXCD, r = nwg % NXCD, xcd = wgid % NXCD, off = wgid / NXCD; wgid = (xcd < r ? xcd * (q + 1) : r * (q + 1) + (xcd - r) * q) + off; }
        const int nig = WGM * nN, gid = wgid / nig, fm = gid * WGM, gsz = (nM - fm) < WGM ? (nM - fm) : WGM;
        u.pm = fm + ((wgid % nig) % gsz); u.pn = (wgid % nig) / gsz; return true;
    }
    __device__ __forceinline__ const char* abase(const Unit& u) const {
        if (MODE == 1) { const int b = u.pm / FT, i = u.pm % FT; return A0 + ((size_t)b * PADROWS + (size_t)254 * i) * (size_t)K * 2; }
        if (MODE == 2) return (u.pn < 2 ? A0 : A1) + (size_t)u.pm * 256 * K * 2;
        return A0 + (size_t)u.pm * 256 * K * 2;
    }
    __device__ __forceinline__ const char* bbase(const Unit& u) const { return B + (size_t)u.pn * 256 * K * 2; }
};
typedef const f32x4 (&AccRef)[2][2][4][2];

struct EpiBf16 {
    static constexpr bool PERM = true;
    bf16_t* O; int ldc; int split_cols; size_t split_stride; float scale0;
    __device__ __forceinline__ void operator()(AccRef acc, const Unit& u, int wr, int wc, int fr_in, int fq_in, PG8_LAS unsigned char*) const {
        int fr = fr_in, fq = fq_in; asm volatile("" : "+v"(fr), "+v"(fq));
        const int row0 = u.pm * BM + wr * 64 + fr; int colt = u.pn * BM; bf16_t* base = O;
        float sc = 1.f; if (split_cols) { const int t = colt / split_cols; base += (size_t)t * split_stride; colt -= t * split_cols; if (t == 0) sc = scale0; }
        const int col0 = colt + wc * 32 + 8 * fq;
#pragma unroll
        for (int ai = 0; ai < 2; ++ai)
#pragma unroll
            for (int m = 0; m < 4; ++m) { bf16_t* rowp = base + (size_t)(row0 + ai * HALF + m * 16) * ldc + col0;
#pragma unroll
                for (int bj = 0; bj < 2; ++bj) { f32x4 v0 = acc[ai][bj][m][0] * sc, v1 = acc[ai][bj][m][1] * sc;
                    u32x4 w; w.x = cvt_pk_bf16(v0[0], v0[1]); w.y = cvt_pk_bf16(v0[2], v0[3]); w.z = cvt_pk_bf16(v1[0], v1[1]); w.w = cvt_pk_bf16(v1[2], v1[3]);
                    *(u32x4*)(rowp + bj * HALF) = w; } }
    }
};
struct EpiRes {
    static constexpr bool PERM = false;
    const float* hin; float* hout; const float* gate;
    __device__ __forceinline__ void operator()(AccRef acc, const Unit& u, int wr, int wc, int fr_in, int fq_in, PG8_LAS unsigned char*) const {
        int fr = fr_in, fq = fq_in; asm volatile("" : "+v"(fr), "+v"(fq));
        const int row0 = u.pm * BM + wr * 64 + fr, col0 = u.pn * BM + wc * 32 + 4 * fq, b = (u.pm * BM) / SEQ;
        const float* gp = gate + (size_t)b * 6144 + col0;
        f32x4 gv[2][2];
#pragma unroll
        for (int bj = 0; bj < 2; ++bj)
#pragma unroll
            for (int n = 0; n < 2; ++n) gv[bj][n] = *(const f32x4*)(gp + bj * HALF + n * 16);
#pragma unroll
        for (int ai = 0; ai < 2; ++ai)
#pragma unroll
            for (int m = 0; m < 4; ++m) { const size_t off = (size_t)(row0 + ai * HALF + m * 16) * DM + col0;
#pragma unroll
                for (int bj = 0; bj < 2; ++bj)
#pragma unroll
                    for (int n = 0; n < 2; ++n) { const f32x4 bs = *(const f32x4*)(hin + off + bj * HALF + n * 16);
                        *(f32x4*)(hout + off + bj * HALF + n * 16) = bs + gv[bj][n] * acc[ai][bj][m][n]; }
                if (m & 1) asm volatile("" ::: "memory"); }
    }
};
struct EpiConv {
    static constexpr bool PERM = true;
    const float* cw; const float* cb; bf16_t* act;
    __device__ __forceinline__ void operator()(AccRef acc, const Unit& u, int wr, int wc, int fr_in, int fq_in, PG8_LAS unsigned char* lds) const {
        int fr = fr_in, fq = fq_in; asm volatile("" : "+v"(fr), "+v"(fq));
        PG8_LAS f32x4* X = (PG8_LAS f32x4*)(lds + XCH_OFF);
        const int lane = fr + 16 * fq;
        if (fr >= 14) {
#pragma unroll
            for (int ai = 0; ai < 2; ++ai)
#pragma unroll
                for (int bj = 0; bj < 2; ++bj)
#pragma unroll
                    for (int n = 0; n < 2; ++n) X[((((((ai * 2 + wr) * 2 + (fr - 14)) * 4 + wc) * 2 + bj) * 2 + n) * 4) + fq] = acc[ai][bj][3][n];
        }
        asm volatile("s_waitcnt lgkmcnt(0)" ::: "memory"); __builtin_amdgcn_s_barrier(); asm volatile("" ::: "memory");
        const int b = u.pm / FT, it = u.pm % FT;
        const int src1 = (lane & 48) | ((lane - 1) & 15), src2 = (lane & 48) | ((lane - 2) & 15);
#pragma unroll
        for (int n = 0; n < 2; ++n) {
            const int gc = 128 * u.pn + 32 * wc + 8 * fq + 4 * n;
            const f32x4 wg0 = *(const f32x4*)(cw + gc), wg1 = *(const f32x4*)(cw + FFN2 + gc), wg2 = *(const f32x4*)(cw + 2 * FFN2 + gc), bg = *(const f32x4*)(cb + gc);
            const f32x4 wv0 = *(const f32x4*)(cw + FFN + gc), wv1 = *(const f32x4*)(cw + FFN2 + FFN + gc), wv2 = *(const f32x4*)(cw + 2 * FFN2 + FFN + gc), bv = *(const f32x4*)(cb + FFN + gc);
#pragma unroll
            for (int ai = 0; ai < 2; ++ai) {
                const int G = ai * 2 + wr;
                f32x4 pg = (f32x4){0.f, 0.f, 0.f, 0.f}, pv = pg;
                if (G > 0) {
                    const int rr = (fr == 15) ? 1 : 0;
                    pg = X[((((((G - 1) * 2 + rr) * 4 + wc) * 2 + 0) * 2 + n) * 4) + fq];
                    pv = X[((((((G - 1) * 2 + rr) * 4 + wc) * 2 + 1) * 2 + n) * 4) + fq];
                }
#pragma unroll
                for (int m = 0; m < 4; ++m) {
                    const f32x4 cg = acc[ai][0][m][n], cv = acc[ai][1][m][n];
                    const f32x4 qg = (m == 0) ? pg : acc[ai][0][m > 0 ? m - 1 : 0][n], qv = (m == 0) ? pv : acc[ai][1][m > 0 ? m - 1 : 0][n];
                    float o[4];
#pragma unroll
                    for (int e = 0; e < 4; ++e) {
                        const float g1c = lane_read(cg[e], src1), g1p = lane_read(qg[e], src1), g2c = lane_read(cg[e], src2), g2p = lane_read(qg[e], src2);
                        const float v1c = lane_read(cv[e], src1), v1p = lane_read(qv[e], src1), v2c = lane_read(cv[e], src2), v2p = lane_read(qv[e], src2);
                        const float g1 = fr >= 1 ? g1c : g1p, g2 = fr >= 2 ? g2c : g2p, v1 = fr >= 1 ? v1c : v1p, v2 = fr >= 2 ? v2c : v2p;
                        const float yg = bg[e] + wg0[e] * g2 + wg1[e] * g1 + wg2[e] * cg[e];
                        const float yv = bv[e] + wv0[e] * v2 + wv1[e] * v1 + wv2[e] * cv[e];
                        const float sg = yg * __builtin_amdgcn_rcpf(1.0f + __builtin_amdgcn_exp2f(-yg * LOG2E));
                        o[e] = sg * yv;
                    }
                    const int R = ai * HALF + wr * 64 + m * 16 + fr, tok = 254 * it - 2 + R;
                    if (R >= 2 && tok < SEQ) { u32x2 w; w.x = cvt_pk_bf16(o[0], o[1]); w.y = cvt_pk_bf16(o[2], o[3]);
                        *(u32x2*)(act + ((size_t)b * SEQ + tok) * FFN + gc) = w; }
                }
            }
        }
    }
};
struct EpiLatDown {
    static constexpr bool PERM = false;
    bf16_t* ckv; bf16_t* cq; bf16_t* kr; float* ssqkv; float* ssqq; const float* cosT; const float* sinT;
    __device__ __forceinline__ void operator()(AccRef acc, const Unit& u, int wr, int wc, int fr_in, int fq_in, PG8_LAS unsigned char*) const {
        int fr = fr_in, fq = fq_in; asm volatile("" : "+v"(fr), "+v"(fq));
        const int row0 = u.pm * BM + wr * 64 + fr, cl = wc * 32 + 4 * fq;
        if (u.pn == 1) {
            if (wc == 0) {
#pragma unroll
                for (int ai = 0; ai < 2; ++ai)
#pragma unroll
                    for (int m = 0; m < 4; ++m) { const int row = row0 + ai * HALF + m * 16;
                        const f32x4 c = *(const f32x4*)(cosT + (size_t)row * 16 + 4 * fq), s = *(const f32x4*)(sinT + (size_t)row * 16 + 4 * fq);
                        const f32x4 t1 = acc[ai][0][m][0], t2 = acc[ai][0][m][1];
                        const f32x4 o1 = t1 * c - t2 * s, o2 = t2 * c + t1 * s;
                        u32x2 w1, w2; w1.x = cvt_pk_bf16(o1[0], o1[1]); w1.y = cvt_pk_bf16(o1[2], o1[3]); w2.x = cvt_pk_bf16(o2[0], o2[1]); w2.y = cvt_pk_bf16(o2[2], o2[3]);
                        *(u32x2*)(kr + (size_t)row * ROPE + 4 * fq) = w1; *(u32x2*)(kr + (size_t)row * ROPE + 16 + 4 * fq) = w2; }
            }
            return;
        }
        const bool isq = u.pn >= 2; const int cbase = isq ? (u.pn - 2) * 256 : 0, ld = isq ? QL : KVL; bf16_t* O = isq ? cq : ckv;
#pragma unroll
        for (int ai = 0; ai < 2; ++ai)
#pragma unroll
            for (int m = 0; m < 4; ++m) { const int row = row0 + ai * HALF + m * 16; float ss = 0.f;
#pragma unroll
                for (int bj = 0; bj < 2; ++bj)
#pragma unroll
                    for (int n = 0; n < 2; ++n) { const f32x4 v = acc[ai][bj][m][n]; ss += (v[0] * v[0] + v[1] * v[1]) + (v[2] * v[2] + v[3] * v[3]);
                        const int c = cbase + bj * HALF + cl + n * 16;
                        if (c < ld) { u32x2 w; w.x = cvt_pk_bf16(v[0], v[1]); w.y = cvt_pk_bf16(v[2], v[3]); *(u32x2*)(O + (size_t)row * ld + c) = w; } }
                ss += lane_read(ss, (fr + 16 * fq) ^ 16); ss += lane_read(ss, (fr + 16 * fq) ^ 32);
                if (fq == 0) { if (isq) ssqq[(size_t)row * 8 + (u.pn - 2) * 4 + wc] = ss; else ssqkv[(size_t)row * 4 + wc] = ss; } }
    }
};
template <bool ISQ> struct EpiLatUp {
    static constexpr bool PERM = false;
    bf16_t* O0; bf16_t* O1; const float* ssq; const float* cosT; const float* sinT;
    __device__ __forceinline__ void operator()(AccRef acc, const Unit& u, int wr, int wc, int fr_in, int fq_in, PG8_LAS unsigned char*) const {
        int fr = fr_in, fq = fq_in; asm volatile("" : "+v"(fr), "+v"(fq));
        const int row0 = u.pm * BM + wr * 64 + fr, cl = wc * 32 + 4 * fq;
        const bool second = u.pn >= 4; const int ct = (second ? u.pn - 4 : u.pn) * 256; bf16_t* O = second ? O1 : O0; constexpr int ld = DM;
#pragma unroll
        for (int ai = 0; ai < 2; ++ai)
#pragma unroll
            for (int m = 0; m < 4; ++m) { const int row = row0 + ai * HALF + m * 16; float rs;
                if (ISQ) { const f32x4 a = *(const f32x4*)(ssq + (size_t)row * 8), b2 = *(const f32x4*)(ssq + (size_t)row * 8 + 4);
                    rs = __builtin_amdgcn_rsqf((((a[0] + a[1]) + (a[2] + a[3])) + ((b2[0] + b2[1]) + (b2[2] + b2[3]))) * (1.0f / QL) + EPS) * QS_B; }
                else { const f32x4 a = *(const f32x4*)(ssq + (size_t)row * 4); rs = __builtin_amdgcn_rsqf(((a[0] + a[1]) + (a[2] + a[3])) * (1.0f / KVL) + EPS); }
                asm volatile("" : "+v"(rs) :: "memory");
                if (ISQ && second) {
                    const f32x4 c = *(const f32x4*)(cosT + (size_t)row * 16 + 4 * fq), s = *(const f32x4*)(sinT + (size_t)row * 16 + 4 * fq);
#pragma unroll
                    for (int bj = 0; bj < 2; ++bj) { const f32x4 t1 = acc[ai][bj][m][0] * rs, t2 = acc[ai][bj][m][1] * rs;
                        const f32x4 o1 = t1 * c - t2 * s, o2 = t2 * c + t1 * s;
                        u32x2 w1, w2; w1.x = cvt_pk_bf16(o1[0], o1[1]); w1.y = cvt_pk_bf16(o1[2], o1[3]); w2.x = cvt_pk_bf16(o2[0], o2[1]); w2.y = cvt_pk_bf16(o2[2], o2[3]);
                        bf16_t* p = O + (size_t)row * ld + ct + bj * HALF + cl; *(u32x2*)p = w1; *(u32x2*)(p + 16) = w2; asm volatile("" ::: "memory"); }
                } else {
#pragma unroll
                    for (int bj = 0; bj < 2; ++bj)
#pragma unroll
                        for (int n = 0; n < 2; ++n) { const f32x4 v = acc[ai][bj][m][n] * rs; u32x2 w; w.x = cvt_pk_bf16(v[0], v[1]); w.y = cvt_pk_bf16(v[2], v[3]);
                            *(u32x2*)(O + (size_t)row * ld + ct + bj * HALF + cl + n * 16) = w; }
                }
                asm volatile("" ::: "memory"); }
    }
};
template <class Epi, class Sched, bool ALIGN_EPI = false, bool SP2 = false>
__device__ __forceinline__ void gemm_phase(PG8_LAS unsigned char* lds, const int K, const Sched& S, const Epi& E) {
    int tid_ = threadIdx.x; asm volatile("" : "+v"(tid_));
    const int tid = tid_, wid = __builtin_amdgcn_readfirstlane(tid >> 6), lane = tid & 63, wr = wid >> 2, wc = wid & 3, fr = lane & 15, fq = lane >> 4;
    const int nt = K / BK;
    unsigned voffA[2], voffB[2];
#pragma unroll
    for (int i = 0; i < 2; ++i) { int R, C; stage_rc(tid * 16 + i * 8192, R, C); const int Rb = Epi::PERM ? ((R & ~31) + perm32(R & 31)) : R;
        voffA[i] = (unsigned)(R * K + C) * 2u; voffB[i] = (unsigned)(Rb * K + C) * 2u; }
    const size_t kstep = (size_t)(BK * 2);
    const size_t hstep = (size_t)HALF * K * 2;
    const unsigned ldsw = (unsigned)wid * 1024u;
    const int aoff = lds_byte(wr * 64 + fr, fq * 8), boff = lds_byte(wc * 32 + fr, fq * 8);
#define PG8_SA(b, h) (((b) * 2 + (h)) * HTB)
#define PG8_SB(b, h) ((4 + (b) * 2 + (h)) * HTB)
#define PG8_STAGE(bufoff, gbase, voff) do { _Pragma("unroll") for (int _i = 0; _i < 2; ++_i) \
        __builtin_amdgcn_global_load_lds((const unsigned*)((const char*)(gbase) + (voff)[_i]), (PG8_LAS unsigned*)(lds + (bufoff) + ldsw + _i * 8192), 16, 0, 0); } while (0)
#define PG8_LDA(dst, b, h) do { _Pragma("unroll") for (int m = 0; m < 4; ++m) _Pragma("unroll") for (int k = 0; k < 2; ++k) dst[m][k] = *(const PG8_LAS bf16x8*)(lds + PG8_SA(b, h) + aoff + m * 2048 + k * 1024); } while (0)
#define PG8_LDB(dst, b, h) do { _Pragma("unroll") for (int n = 0; n < 2; ++n) _Pragma("unroll") for (int k = 0; k < 2; ++k) dst[n][k] = *(const PG8_LAS bf16x8*)(lds + PG8_SB(b, h) + boff + n * 2048 + k * 1024); } while (0)
#define PG8_MMA(ai, bj, At, Bt) do { __builtin_amdgcn_s_setprio(1); _Pragma("unroll") for (int m = 0; m < 4; ++m) _Pragma("unroll") for (int n = 0; n < 2; ++n) _Pragma("unroll") for (int k = 0; k < 2; ++k) \
        acc[ai][bj][m][n] = __builtin_amdgcn_mfma_f32_16x16x32_bf16(Bt[n][k], At[m][k], acc[ai][bj][m][n], 0, 0, 0); __builtin_amdgcn_s_setprio(0); } while (0)
#define PG8_WAIT_V(n) asm volatile("s_waitcnt vmcnt(" #n ")" ::: "memory")
#define PG8_WAIT_L(n) asm volatile("s_waitcnt lgkmcnt(" #n ")" ::: "memory")
#define PG8_BAR __builtin_amdgcn_s_barrier()
#define PG8_SCHED __builtin_amdgcn_sched_barrier(0)
    Unit cur, nxt; int ui = 0;
    if (!S.next(0, cur)) return;
    f32x4 acc[2][2][4][2];
#pragma unroll
    for (int a = 0; a < 2; ++a)
#pragma unroll
        for (int b = 0; b < 2; ++b)
#pragma unroll
            for (int m = 0; m < 4; ++m)
#pragma unroll
                for (int n = 0; n < 2; ++n) acc[a][b][m][n] = (f32x4){0.f, 0.f, 0.f, 0.f};
    bf16x8 At[4][2], B0[2][2], B1[2][2];
    const char* cA = S.abase(cur); const char* cB = S.bbase(cur);
    if constexpr (SP2) {
        PG8_STAGE(PG8_SB(0, 0), cB, voffB); PG8_STAGE(PG8_SB(0, 1), cB + hstep, voffB); PG8_STAGE(PG8_SA(0, 0), cA, voffA); PG8_STAGE(PG8_SA(0, 1), cA + hstep, voffA);
        if (wr == 1) PG8_BAR;
        PG8_WAIT_V(2); PG8_BAR;
        PG8_STAGE(PG8_SB(1, 0), cB + kstep, voffB); PG8_STAGE(PG8_SA(1, 0), cA + kstep, voffA); PG8_STAGE(PG8_SB(1, 1), cB + hstep + kstep, voffB);
        PG8_WAIT_V(6); PG8_BAR;
    } else {
        PG8_STAGE(PG8_SB(0, 0), cB, voffB); PG8_STAGE(PG8_SA(0, 0), cA, voffA); PG8_STAGE(PG8_SB(0, 1), cB + hstep, voffB); PG8_STAGE(PG8_SA(0, 1), cA + hstep, voffA);
        if (wr == 1) PG8_BAR;
        PG8_WAIT_V(4); PG8_BAR;
        PG8_STAGE(PG8_SB(1, 0), cB + kstep, voffB); PG8_STAGE(PG8_SA(1, 0), cA + kstep, voffA); PG8_STAGE(PG8_SB(1, 1), cB + hstep + kstep, voffB);
        PG8_WAIT_V(6); PG8_BAR;
    }
    for (;;) {
        const bool has_next = S.next(ui + 1, nxt);
        const char* nA = has_next ? S.abase(nxt) : cA; const char* nB = has_next ? S.bbase(nxt) : cB;
        for (int t = 0; t < nt; t += 2) {
            const bool last = (t == nt - 2);
            const char* a1 = cA + (size_t)(t + 1) * kstep;
            const char* a2 = last ? nA : cA + (size_t)(t + 2) * kstep; const char* b2 = last ? nB : cB + (size_t)(t + 2) * kstep;
            const char* a3 = a2 + kstep; const char* b3 = b2 + kstep;
            if constexpr (SP2) {
            PG8_LDB(B0, 0, 0); PG8_LDB(B1, 0, 1); PG8_SCHED; PG8_LDA(At, 0, 0); PG8_STAGE(PG8_SA(1, 1), a1 + hstep, voffA);
            PG8_WAIT_V(8); PG8_WAIT_L(0); PG8_BAR; PG8_MMA(0, 0, At, B0); PG8_MMA(0, 1, At, B1); PG8_BAR; PG8_SCHED;
            PG8_LDA(At, 0, 1); PG8_STAGE(PG8_SB(0, 0), b2, voffB); PG8_STAGE(PG8_SB(0, 1), b2 + hstep, voffB); PG8_STAGE(PG8_SA(0, 0), a2, voffA);
            PG8_WAIT_V(8); PG8_WAIT_L(0); PG8_BAR; PG8_MMA(1, 0, At, B0); PG8_MMA(1, 1, At, B1); PG8_BAR; PG8_SCHED;
            PG8_LDB(B0, 1, 0); PG8_LDB(B1, 1, 1); PG8_SCHED; PG8_LDA(At, 1, 0); PG8_STAGE(PG8_SA(0, 1), a2 + hstep, voffA);
            PG8_WAIT_V(8); PG8_WAIT_L(0); PG8_BAR; PG8_MMA(0, 0, At, B0); PG8_MMA(0, 1, At, B1); PG8_BAR; PG8_SCHED;
            PG8_LDA(At, 1, 1); PG8_STAGE(PG8_SB(1, 0), b3, voffB); PG8_STAGE(PG8_SB(1, 1), b3 + hstep, voffB); PG8_STAGE(PG8_SA(1, 0), a3, voffA);
            PG8_WAIT_V(8); PG8_WAIT_L(0); PG8_BAR; PG8_MMA(1, 0, At, B0); PG8_MMA(1, 1, At, B1); PG8_BAR; PG8_SCHED;
            } else {
            PG8_LDB(B0, 0, 0); PG8_SCHED; PG8_LDA(At, 0, 0); PG8_STAGE(PG8_SA(1, 1), a1 + hstep, voffA);
            PG8_WAIT_L(8); PG8_BAR; PG8_WAIT_L(0); PG8_MMA(0, 0, At, B0); PG8_BAR; PG8_SCHED;
            PG8_LDB(B1, 0, 1); PG8_STAGE(PG8_SB(0, 0), b2, voffB);
            PG8_BAR; PG8_WAIT_L(0); PG8_MMA(0, 1, At, B1); PG8_BAR;
            PG8_LDA(At, 0, 1); PG8_STAGE(PG8_SA(0, 0), a2, voffA);
            PG8_BAR; PG8_WAIT_L(0); PG8_MMA(1, 0, At, B0); PG8_BAR; PG8_SCHED;
            PG8_STAGE(PG8_SB(0, 1), b2 + hstep, voffB);
            PG8_WAIT_V(6); PG8_BAR; PG8_MMA(1, 1, At, B1); PG8_BAR;
            PG8_LDB(B0, 1, 0); PG8_SCHED; PG8_LDA(At, 1, 0); PG8_STAGE(PG8_SA(0, 1), a2 + hstep, voffA);
            PG8_WAIT_L(8); PG8_BAR; PG8_WAIT_L(0); PG8_MMA(0, 0, At, B0); PG8_BAR; PG8_SCHED;
            PG8_LDB(B1, 1, 1); PG8_STAGE(PG8_SB(1, 0), b3, voffB);
            PG8_BAR; PG8_WAIT_L(0); PG8_MMA(0, 1, At, B1); PG8_BAR;
            PG8_LDA(At, 1, 1); PG8_STAGE(PG8_SA(1, 0), a3, voffA);
            PG8_BAR; PG8_WAIT_L(0); PG8_MMA(1, 0, At, B0); PG8_BAR; PG8_SCHED;
            PG8_STAGE(PG8_SB(1, 1), b3 + hstep, voffB);
            PG8_WAIT_V(6); PG8_BAR; PG8_MMA(1, 1, At, B1); PG8_BAR;
            }
        }
        if constexpr (ALIGN_EPI) { if (wr == 0) PG8_BAR; }
        E(acc, cur, wr, wc, fr, fq, lds);
        if (!has_next) break;
#pragma unroll
        for (int a = 0; a < 2; ++a)
#pragma unroll
            for (int b = 0; b < 2; ++b)
#pragma unroll
                for (int m = 0; m < 4; ++m)
#pragma unroll
                    for (int n = 0; n < 2; ++n) acc[a][b][m][n] = (f32x4){0.f, 0.f, 0.f, 0.f};
        cur = nxt; cA = nA; cB = nB; ++ui;
        if constexpr (ALIGN_EPI) { if (wr == 1) PG8_BAR; }
    }
    PG8_WAIT_V(0);
    if constexpr (!ALIGN_EPI) { if (wr == 0) PG8_BAR; }
    PG8_BAR;
#undef PG8_SA
#undef PG8_SB
#undef PG8_STAGE
#undef PG8_LDA
#undef PG8_LDB
#undef PG8_MMA
#undef PG8_WAIT_V
#undef PG8_WAIT_L
#undef PG8_BAR
#undef PG8_SCHED
}
}
namespace att {
__device__ __forceinline__ int crow(int r, int hi) { return (r & 3) + 8 * (r >> 2) + 4 * hi; }
typedef short v4i16_t __attribute__((ext_vector_type(4)));
__device__ __forceinline__ s16x4 vtr(const LAS unsigned char* p) { return __builtin_bit_cast(s16x4, __builtin_amdgcn_ds_read_tr16_b64_v4i16((LAS v4i16_t*)p)); }
#define MFMA32(a, b, c) __builtin_amdgcn_mfma_f32_32x32x16_bf16((a), (b), (c), 0, 0, 0)

template <int DQK, bool BIAS, int NB>
__device__ __forceinline__ void attn_unit(LAS unsigned char* lds, int b, int h, int q0, const bf16_t* Qn, const bf16_t* Qr, const bf16_t* Kn, const bf16_t* Kr,
                                          const bf16_t* Vg, bf16_t* Og, const float* biasg) {
    constexpr int NC = DQK / 8, KSZ = NC * 1024, ND = DQK / 16;
    constexpr int OFF_V = 2 * KSZ, OFF_WSF = OFF_V + 3 * 8192, OFF_BT = OFF_WSF + 8 * 64 * NB * 4;
    int tid_ = threadIdx.x; asm volatile("" : "+v"(tid_));
    const int tid = tid_, lane = tid & 63, r32 = lane & 31, hi = lane >> 5; const int wid = __builtin_amdgcn_readfirstlane(tid >> 6);
    const bool grpA = wid < 4;
    const size_t rowbase = (size_t)b * SEQ;
    const int qw = q0 + wid * 32 * NB;
    const int cwv = qw >> 6, c0 = q0 >> 6;
    const int tlo = BIAS ? (c0 - 8 > 0 ? c0 - 8 : 0) : 0, thi = c0 + 4 * NB;
    const int wlo = BIAS ? (cwv - 8 > 0 ? cwv - 8 : 0) : 0, whi = cwv;
    LAS float* wsf = (LAS float*)(lds + OFF_WSF) + wid * 64 * NB;
    LAS float* bt = (LAS float*)(lds + OFF_BT);
    bf16x8 qf[NB][ND];
#pragma unroll
    for (int nb = 0; nb < NB; ++nb) {
        const size_t qrow = rowbase + qw + nb * 32 + r32;
#pragma unroll
        for (int d0 = 0; d0 < 4; ++d0) qf[nb][d0] = *(const bf16x8*)(Qn + qrow * DM + h * 64 + d0 * 16 + hi * 8);
        if constexpr (DQK == 96) {
#pragma unroll
            for (int d0 = 4; d0 < 6; ++d0) qf[nb][d0] = *(const bf16x8*)(Qr + qrow * DM + h * 32 + (d0 - 4) * 16 + hi * 8);
        }
    }
    if constexpr (BIAS) { for (int i = tid; i < 257; i += 512) bt[i] = biasg[i] * LOG2E; }
    const int ka_key = tid / NC, ka_c = tid % NC, kb_key = (tid + 512) / NC, kb_c = (tid + 512) % NC, v_key = tid >> 3, v_c = tid & 7;
    const bool has_kb = (DQK == 96) && (tid < 256);
    const int ka_dst = ka_c * 1024 + ka_key * 16, kb_dst = kb_c * 1024 + kb_key * 16;
    const int v_dst = (v_c >> 2) * 4096 + (v_key >> 4) * 1024 + (v_key & 15) * 64 + (v_c & 3) * 16;
    const bf16_t* pa_src = (ka_c < 8) ? Kn + (rowbase + ka_key) * DM + h * 64 + ka_c * 8 : Kr + (rowbase + ka_key) * ROPE + (ka_c - 8) * 8;
    const bf16_t* pb_src = (kb_c < 8) ? Kn + (rowbase + kb_key) * DM + h * 64 + kb_c * 8 : Kr + (rowbase + kb_key) * ROPE + (kb_c - 8) * 8;
    const int pa_step = (ka_c < 8) ? 64 * DM : 64 * ROPE, pb_step = (kb_c < 8) ? 64 * DM : 64 * ROPE;
    const bf16_t* pv_src = Vg + (rowbase + v_key) * DM + h * 64 + v_c * 8;
    u32x4 ra, rb, rv;
#define ATT_LOAD(t) do { ra = *(const u32x4*)(pa_src + (size_t)(t) * pa_step); if (has_kb) rb = *(const u32x4*)(pb_src + (size_t)(t) * pb_step); rv = *(const u32x4*)(pv_src + (size_t)(t) * 64 * DM); } while (0)
#define ATT_STORE(kbuf, vbuf) do { *(LAS u32x4*)(lds + (kbuf) * KSZ + ka_dst) = ra; if (has_kb) *(LAS u32x4*)(lds + (kbuf) * KSZ + kb_dst) = rb; \
        *(LAS u32x4*)(lds + OFF_V + (vbuf) * 8192 + v_dst) = rv; } while (0)
    rb = (u32x4){0u, 0u, 0u, 0u};
    ATT_LOAD(tlo); ATT_STORE(0, 0);
    __syncthreads();
    float mrun[NB], lrun[NB]; f32x16 o0[NB], o1[NB], p[NB]; u32x4 pw[NB][2];
#pragma unroll
    for (int nb = 0; nb < NB; ++nb) { mrun[nb] = 0.f; lrun[nb] = 0.f; o0[nb] = (f32x16){}; o1[nb] = (f32x16){}; p[nb] = (f32x16){}; pw[nb][0] = (u32x4){0u, 0u, 0u, 0u}; pw[nb][1] = (u32x4){0u, 0u, 0u, 0u}; }
    const int vrd = (4 * hi + ((lane & 15) >> 2)) * 64 + ((lane >> 4) & 1) * 32 + (lane & 3) * 8;
#define ATT_QK(kbuf, half) do { const LAS unsigned char* Kb = lds + (kbuf) * KSZ + hi * 1024 + ((half) * 32 + r32) * 16; \
    _Pragma("unroll") for (int nb = 0; nb < NB; ++nb) p[nb] = (f32x16){}; \
    _Pragma("unroll") for (int d0 = 0; d0 < ND; ++d0) { const bf16x8 k0 = *(const LAS bf16x8*)(Kb + d0 * 2048); \
        _Pragma("unroll") for (int nb = 0; nb < NB; ++nb) p[nb] = MFMA32(k0, qf[nb][d0], p[nb]); } } while (0)
#define ATT_PV(vbuf, half) do { const LAS unsigned char* Vb = lds + OFF_V + (vbuf) * 8192 + vrd + (half) * 2048; \
    _Pragma("unroll") for (int ks = 0; ks < 2; ++ks) { \
        const s16x4 a0 = vtr(Vb + ks * 1024), a1 = vtr(Vb + ks * 1024 + 512), c0_ = vtr(Vb + 4096 + ks * 1024), c1_ = vtr(Vb + 4096 + ks * 1024 + 512); \
        const bf16x8 v0 = (bf16x8){a0[0], a0[1], a0[2], a0[3], a1[0], a1[1], a1[2], a1[3]}, v1 = (bf16x8){c0_[0], c0_[1], c0_[2], c0_[3], c1_[0], c1_[1], c1_[2], c1_[3]}; \
        _Pragma("unroll") for (int nb = 0; nb < NB; ++nb) { const bf16x8 pa = __builtin_bit_cast(bf16x8, pw[nb][ks]); o0[nb] = MFMA32(pa, v0, o0[nb]); o1[nb] = MFMA32(pa, v1, o1[nb]); } } } while (0)
#define ATT_SOFTMAX(ts, half) do { \
    _Pragma("unroll") for (int nb = 0; nb < NB; ++nb) { \
        if constexpr (BIAS) { const int dbase = qw + nb * 32 - (ts) * 64 - (half) * 32; \
            if (dbase - 31 >= 128) { const float cb = bt[256]; _Pragma("unroll") for (int i = 0; i < 16; ++i) p[nb][i] += cb; } \
            else { _Pragma("unroll") for (int i = 0; i < 16; ++i) { const int d = dbase + r32 - crow(i, hi); p[nb][i] += bt[(d < 128 ? d : 128) + 128]; } } } \
        float ra_ = fmaxf(fmaxf(p[nb][0], p[nb][1]), p[nb][2]), rb_ = fmaxf(fmaxf(p[nb][3], p[nb][4]), p[nb][5]); \
        _Pragma("unroll") for (int i = 6; i < 14; i += 4) { ra_ = fmaxf(fmaxf(ra_, p[nb][i]), p[nb][i + 1]); rb_ = fmaxf(fmaxf(rb_, p[nb][i + 2]), p[nb][i + 3]); } \
        float rm = fmaxf(fmaxf(ra_, rb_), fmaxf(p[nb][14], p[nb][15])); \
        rm = fmaxf(rm, lane_read(rm, lane ^ 32)); \
        if ((ts) == wlo && (half) == 0) { mrun[nb] = rm; } \
        else if (__any(rm > mrun[nb] + 8.0f)) { \
            const float dl = fmaxf(rm - mrun[nb], 0.f); const float al = __builtin_amdgcn_exp2f(-dl); mrun[nb] += dl; lrun[nb] *= al; \
            if (hi == 0) wsf[nb * 64 + r32] = al; \
            _Pragma("unroll") for (int i = 0; i < 16; ++i) { const float a = wsf[nb * 64 + crow(i, hi)]; o0[nb][i] *= a; o1[nb][i] *= a; } } \
        float ls0 = 0.f, ls1 = 0.f; const float mm = mrun[nb]; \
        _Pragma("unroll") for (int i = 0; i < 16; i += 2) { p[nb][i] = __builtin_amdgcn_exp2f(p[nb][i] - mm); p[nb][i + 1] = __builtin_amdgcn_exp2f(p[nb][i + 1] - mm); ls0 += p[nb][i]; ls1 += p[nb][i + 1]; } \
        lrun[nb] += ls0 + ls1; \
        _Pragma("unroll") for (int k = 0; k < 4; ++k) { pw[nb][0][k] = cvt_pk_bf16(p[nb][2 * k], p[nb][2 * k + 1]); pw[nb][1][k] = cvt_pk_bf16(p[nb][8 + 2 * k], p[nb][8 + 2 * k + 1]); } } } while (0)

#define ATT_LOOP(BODY) do { int kcur = 0, vcur = 0, vprv = 2;     \
    for (int t = tlo; t <= thi; ++t) { \
        const bool more = (t + 1 < thi); \
        if (more) ATT_LOAD(t + 1); \
        const bool vp = (t - 1 >= wlo) && (t - 1 <= whi), vc = (t >= wlo) && (t <= whi); \
        BODY \
        const int vnxt = (vcur == 2) ? 0 : vcur + 1; \
        if (more) ATT_STORE(kcur ^ 1, vnxt); \
        __syncthreads(); \
        kcur ^= 1; vprv = vcur; vcur = vnxt; } } while (0)
    if (grpA) { ATT_LOOP( if (vp) ATT_PV(vprv, 1); if (vc) { ATT_QK(kcur, 0); ATT_SOFTMAX(t, 0); ATT_PV(vcur, 0); ATT_QK(kcur, 1); ATT_SOFTMAX(t, 1); } ); }
    else      { ATT_LOOP( if (vp) { ATT_SOFTMAX(t - 1, 1); ATT_PV(vprv, 1); } if (vc) { ATT_QK(kcur, 0); ATT_SOFTMAX(t, 0); ATT_PV(vcur, 0); ATT_QK(kcur, 1); } ); }
#undef ATT_LOOP
#undef ATT_LOAD
#undef ATT_STORE
#undef ATT_QK
#undef ATT_PV
#undef ATT_SOFTMAX
#pragma unroll
    for (int nb = 0; nb < NB; ++nb) {
        float lt = lrun[nb]; lt += lane_read(lt, lane ^ 32);
        if (hi == 0) wsf[nb * 64 + 32 + r32] = lt;
        bf16_t* Ow = Og + (rowbase + qw + nb * 32) * DM + h * 64 + r32;
#pragma unroll
        for (int i = 0; i < 16; ++i) { const int q = crow(i, hi); const float rl = __builtin_amdgcn_rcpf(wsf[nb * 64 + 32 + q]);
            const unsigned w0 = cvt_pk_bf16(o0[nb][i] * rl, 0.f), w1 = cvt_pk_bf16(o1[nb][i] * rl, 0.f);
            Ow[(size_t)q * DM] = (bf16_t)(w0 & 0xffffu); Ow[(size_t)q * DM + 32] = (bf16_t)(w1 & 0xffffu); }
    }
    __syncthreads();
}
#undef MFMA32
}
__device__ const float INV_FREQ[16] = {1.000000000e+00f, 5.623413324e-01f, 3.162277639e-01f, 1.778279394e-01f, 1.000000015e-01f, 5.623413250e-02f, 3.162277490e-02f, 1.778279431e-02f,
                                       9.999999776e-03f, 5.623413250e-03f, 3.162277630e-03f, 1.778279431e-03f, 1.000000047e-03f, 5.623413017e-04f, 3.162277571e-04f, 1.778279402e-04f};
__device__ __forceinline__ unsigned f2bf(float f) { unsigned u = __builtin_bit_cast(unsigned, f); return (u + 0x7fffu + ((u >> 16) & 1u)) >> 16; }
__device__ __forceinline__ unsigned pk2(float lo, float hi) { return f2bf(lo) | (f2bf(hi) << 16); }

struct Params { const void* in[28]; float* out; unsigned char* ws; };
__device__ __forceinline__ const void* karg(int i) { int z = 0; asm volatile("" : "+s"(z)); const void* const* kp = (const void* const*)__builtin_amdgcn_kernarg_segment_ptr(); return kp[i + z]; }
#define KIN(i) ((const float*)karg(i))
#define KOUT ((float*)karg(28))
#define KWS(off) ((unsigned char*)karg(29) + (off))

__device__ __forceinline__ void transpose_item(const float* W, int K, int N, bf16_t* WT, int mode, int row_off, const float* kscale, LAS float* scr, int item, int lane) {
    const int nblk = N / 32, kb = item / nblk, nb = item % nblk, k0 = 64 * kb, n0 = 32 * nb;
#pragma unroll 8
    for (int i = 0; i < 32; ++i) { const int kk = 2 * i + (lane >> 5); float v = W[(size_t)(k0 + kk) * N + n0 + (lane & 31)]; if (kscale) v *= kscale[k0 + kk]; scr[kk * 33 + (lane & 31)] = v; }
    asm volatile("s_waitcnt lgkmcnt(0)" ::: "memory");
    const int c = lane & 7;
#pragma unroll
    for (int j = 0; j < 4; ++j) { const int n = (lane >> 3) + 8 * j; const LAS float* s = scr + (8 * c) * 33 + n;
        u32x4 o; o.x = pk2(s[0 * 33], s[1 * 33]); o.y = pk2(s[2 * 33], s[3 * 33]); o.z = pk2(s[4 * 33], s[5 * 33]); o.w = pk2(s[6 * 33], s[7 * 33]);
        const int nn = n0 + n; int drow;
        if (mode == 0) drow = row_off + nn; else { const int jj = nn < FFN ? nn : nn - FFN; drow = 256 * (jj >> 7) + (nn < FFN ? 0 : 128) + (jj & 127); }
        *(u32x4*)(WT + (size_t)drow * K + k0 + 8 * c) = o; }
    asm volatile("s_waitcnt lgkmcnt(0)" ::: "memory");
}

__device__ __forceinline__ void p0_prologue(LAS unsigned char* lds, int G, int bx) {
    int tid_ = threadIdx.x; asm volatile("" : "+v"(tid_));
    const int tid = tid_, lane = tid & 63; const int wid = __builtin_amdgcn_readfirstlane(tid >> 6);
    unsigned char* ws = KWS(0);
    float* modv = (float*)(ws + WS_MODV);
    {
        LAS float* ca = (LAS float*)lds; LAS float* red = ca + 2048;
        const float* c = KIN(1);
        for (int i = tid; i < 2048; i += 512) { const float v = c[i]; ca[i] = v / (1.0f + __expf(-v)); }
        __syncthreads();
        for (int item = bx; item < 224; item += G) {
            const int col = item * 64; const float* W; const float* bias; float* out; int N, ostride;
            if (col < 12288) { const int l = col / 6144, cc = col % 6144; W = KIN(3) + (size_t)l * 1024 * 6144 + cc; N = 6144; bias = KIN(4) + l * 6144 + cc; out = modv + (size_t)l * 2 * 6144 + cc; ostride = 6144; }
            else { const int cc = col - 12288; W = KIN(10) + cc; N = 2048; bias = KIN(11) + cc; out = modv + 24576 + cc; ostride = 2048; }
            float a0 = 0.f, a1 = 0.f; const int kb = wid * 128;
#pragma unroll 16
            for (int k = 0; k < 128; ++k) { const float w = W[(size_t)(kb + k) * N + lane]; a0 += ca[kb + k] * w; a1 += ca[1024 + kb + k] * w; }
            red[(wid * 2 + 0) * 64 + lane] = a0; red[(wid * 2 + 1) * 64 + lane] = a1;
            __syncthreads();
            if (tid < 128) { const int bb = tid >> 6, ln = tid & 63; float s = 0.f;
#pragma unroll
                for (int w = 0; w < 8; ++w) s += red[(w * 2 + bb) * 64 + ln];
                out[(size_t)bb * ostride + ln] = s + bias[ln]; }
            __syncthreads();
        }
    }
    __syncthreads();
    {
        LAS float* scr = (LAS float*)(lds + wid * 16384);
        const int gw = bx * 8 + wid, NGW = G * 8;
        bf16_t* WQKV = (bf16_t*)(ws + WS_WQKV); bf16_t* WO = (bf16_t*)(ws + WS_WO); bf16_t* WIN = (bf16_t*)(ws + WS_WIN); bf16_t* WOUT = (bf16_t*)(ws + WS_WOUT);
        bf16_t* WLD = (bf16_t*)(ws + WS_WLD); bf16_t* WKVUP = (bf16_t*)(ws + WS_WKVUP); bf16_t* WQUP = (bf16_t*)(ws + WS_WQUP); bf16_t* BWO = (bf16_t*)(ws + WS_BWO);
        constexpr int NITEMS = 1536 + 512 + 2 * 2816 + 2 * 1408 + 128 + 16 + 192 + 128 + 128 + 192 + 96 + 512;
        for (int it = gw; it < NITEMS; it += NGW) {
            int r = it;
            if (r < 1536) { transpose_item(KIN(7), 1024, 3072, WQKV, 0, 0, nullptr, scr, r, lane); continue; } r -= 1536;
            if (r < 512) { transpose_item(KIN(8), 1024, 1024, WO, 0, 0, nullptr, scr, r, lane); continue; } r -= 512;
            if (r < 5632) { const int l = r / 2816; transpose_item(KIN(23) + (size_t)l * 1024 * FFN2, 1024, FFN2, WIN + (size_t)l * FFN2 * 1024, 1, 0, nullptr, scr, r % 2816, lane); continue; } r -= 5632;
            if (r < 2816) { const int l = r / 1408; transpose_item(KIN(26) + (size_t)l * FFN * 1024, FFN, 1024, WOUT + (size_t)l * 1024 * FFN, 0, 0, nullptr, scr, r % 1408, lane); continue; } r -= 2816;
            if (r < 128) { transpose_item(KIN(13), 1024, 256, WLD, 0, 0, nullptr, scr, r, lane); continue; } r -= 128;
            if (r < 16) { transpose_item(KIN(17), 1024, 32, WLD, 0, 256, nullptr, scr, r, lane); continue; } r -= 16;
            if (r < 192) { transpose_item(KIN(18), 1024, 384, WLD, 0, 512, nullptr, scr, r, lane); continue; } r -= 192;
            if (r < 128) { transpose_item(KIN(15), 256, 1024, WKVUP, 0, 0, KIN(14), scr, r, lane); continue; } r -= 128;
            if (r < 128) { transpose_item(KIN(16), 256, 1024, WKVUP, 0, 1024, KIN(14), scr, r, lane); continue; } r -= 128;
            if (r < 192) { transpose_item(KIN(20), 384, 1024, WQUP, 0, 0, KIN(19), scr, r, lane); continue; } r -= 192;
            if (r < 96) { transpose_item(KIN(21), 384, 512, WQUP, 0, 1024, KIN(19), scr, r, lane); continue; } r -= 96;
            transpose_item(KIN(22), 1024, 1024, BWO, 0, 0, nullptr, scr, r, lane);
        }
        const int gt = bx * 512 + tid, NGT = G * 512;
        for (int i = gt; i < 352 * 128; i += NGT) { const int rr = i >> 7, piece = i & 127; const int row = rr < 224 ? 288 + rr : 896 + (rr - 224);
            *(u32x4*)(WLD + (size_t)row * 1024 + piece * 8) = (u32x4){0u, 0u, 0u, 0u}; }
        const int* pos = (const int*)karg(2); float* cosT = (float*)(ws + WS_COS); float* sinT = (float*)(ws + WS_SIN);
        for (int i = gt; i < T * 16; i += NGT) { const int t = i >> 4, j = i & 15; const float ang = (float)pos[t] * INV_FREQ[j];
            const double rev = (double)ang * 0.15915494309189535; const float fr = (float)(rev - rint(rev));
            cosT[i] = __builtin_amdgcn_cosf(fr); sinT[i] = __builtin_amdgcn_sinf(fr); }
    }
}

__device__ __forceinline__ float row_rstd(const float* xrow, int lane, f32x4 (&v)[4]) {
    float s = 0.f;
#pragma unroll
    for (int j = 0; j < 4; ++j) { v[j] = ((const f32x4*)xrow)[64 * j + lane]; s += (v[j].x * v[j].x + v[j].y * v[j].y) + (v[j].z * v[j].z + v[j].w * v[j].w); }
    return __builtin_amdgcn_rsqf(wave_sum(s, lane) * (1.0f / DM) + EPS);
}
__device__ __forceinline__ void mod_store(const f32x4 (&v)[4], float rstd, const float* g, const float* sh, const float* sc, bf16_t* orow, int lane) {
#pragma unroll
    for (int j = 0; j < 4; ++j) { const f32x4 gg = ((const f32x4*)g)[64 * j + lane], ss = ((const f32x4*)sh)[64 * j + lane], cc = ((const f32x4*)sc)[64 * j + lane];
        const f32x4 y = (v[j] * rstd * gg) * (cc + 1.0f) + ss;
        u32x2 w; w.x = cvt_pk_bf16(y.x, y.y); w.y = cvt_pk_bf16(y.z, y.w); ((u32x2*)orow)[64 * j + lane] = w; }
}
#define XB_TMO      128
#define XB_XCNT(j)  (256  + 64 * (j))
#define XB_XSUB(j)  (1280 + 64 * (j))
#define XB_XGEN(j)  (2304 + 64 * (j))
#define XB_TOP      3328
#define XB_TOPGEN   3392
#define XCD_BAR_WORDS 3456
#define XB_SPIN_CAP (1u << 18)

__device__ __forceinline__ unsigned xb_ld(unsigned* p)              { return __hip_atomic_load(p, __ATOMIC_RELAXED, __HIP_MEMORY_SCOPE_AGENT); }
__device__ __forceinline__ unsigned xb_add(unsigned* p, unsigned v) { return __hip_atomic_fetch_add(p, v, __ATOMIC_RELAXED, __HIP_MEMORY_SCOPE_AGENT); }
__device__ __forceinline__ unsigned xb_xcc_id() { return (unsigned)__builtin_amdgcn_s_getreg((3 << 11) | 20) & 0xFu; }
#define XB_SPIN(cond, bar) do { unsigned _sp = 0; while (cond) { __builtin_amdgcn_s_sleep(1); \
    if ((++_sp & 255u) == 0u) { if (xb_ld(&(bar)[XB_TMO])) break; if (_sp > XB_SPIN_CAP) { atomicAdd(&(bar)[XB_TMO], 1u); break; } } } } while (0)

struct XcdBarrier {
    unsigned* bar; unsigned x;
    volatile LAS unsigned* st;
};

__device__ __forceinline__ XcdBarrier xcd_barrier_post(unsigned* bar, volatile LAS unsigned* st) {
    XcdBarrier b; b.bar = bar; b.x = xb_xcc_id(); b.st = st;
    if (threadIdx.x == 0) (void)xb_add(&bar[XB_XCNT(b.x)], 1u);
    return b;
}
__device__ __forceinline__ void xcd_barrier_complete(unsigned* bar, unsigned x, unsigned& nloc, unsigned& nx) {
    const unsigned G = gridDim.x * gridDim.y * gridDim.z;
    unsigned sum, cnt, mine, sp = 0u;
    for (;;) {
        sum = 0u; cnt = 0u; mine = 0u;
#pragma unroll
        for (unsigned j = 0; j < 16; ++j) { const unsigned c = xb_ld(&bar[XB_XCNT(j)]); sum += c; cnt += (c > 0u) ? 1u : 0u; mine = (j == x) ? c : mine; }
        if (sum == G) break;
        __builtin_amdgcn_s_sleep(1);
        if ((++sp & 255u) == 0u) { if (xb_ld(&bar[XB_TMO])) break; if (sp > XB_SPIN_CAP) { atomicAdd(&bar[XB_TMO], 1u); break; } }
    }
    nloc = mine > 0u ? mine : 1u; nx = cnt > 0u ? cnt : 1u;
}

__device__ __forceinline__ void xcd_barrier(const XcdBarrier& b) {
    asm volatile("s_waitcnt vmcnt(0)" ::: "memory");
    __syncthreads();
    if (threadIdx.x == 0) {
        unsigned* bar = b.bar;
        __builtin_amdgcn_s_waitcnt(0);
        unsigned nloc = b.st[0], nx = b.st[1];
        if (nloc == 0u) { xcd_barrier_complete(bar, b.x, nloc, nx); b.st[0] = nloc; b.st[1] = nx; }
        const unsigned old = xb_add(&bar[XB_XSUB(b.x)], 1u);
        const unsigned gen = old / nloc;
        if (old + 1u == (gen + 1u) * nloc) {
            __builtin_amdgcn_fence(__ATOMIC_RELEASE, "agent");
            asm volatile("s_waitcnt vmcnt(0)" ::: "memory");
            const unsigned og = xb_add(&bar[XB_TOP], 1u);
            const unsigned tg = og / nx;
            if (og + 1u == (tg + 1u) * nx) xb_add(&bar[XB_TOPGEN], 1u);
            else XB_SPIN(xb_ld(&bar[XB_TOPGEN]) == tg, bar);
            __builtin_amdgcn_fence(__ATOMIC_ACQUIRE, "agent");
            xb_add(&bar[XB_XGEN(b.x)], 1u);
            asm volatile("s_waitcnt vmcnt(0)" ::: "memory");
        } else {
            XB_SPIN(xb_ld(&bar[XB_XGEN(b.x)]) == gen, bar);
            __builtin_amdgcn_fence(__ATOMIC_ACQUIRE, "agent");
            asm volatile("s_waitcnt vmcnt(0)" ::: "memory");
        }
    }
    __syncthreads();
}

template <class Epi, class S_> __device__ __forceinline__ void run_gemm(LAS unsigned char* lds, int K, const S_& S, const Epi& E) { pg8::gemm_phase<Epi, S_, true, true>(lds, K, S, E); }

__global__ void __launch_bounds__(512) fwd_megakernel(Params P) {
    extern __shared__ __attribute__((aligned(16))) unsigned char lds_raw[];
    LAS unsigned char* lds = (LAS unsigned char*)lds_raw;
    cg::grid_group grid = cg::this_grid();
    const int wid = __builtin_amdgcn_readfirstlane((int)threadIdx.x >> 6);
#define OPAQUE_LANE() unsigned om_ = ~0u; asm volatile("" : "+s"(om_)); int lane = __builtin_amdgcn_mbcnt_hi(om_, __builtin_amdgcn_mbcnt_lo(om_, 0u)); asm volatile("" : "+v"(lane))
#define OPAQUE_GRID() int G = G0, bx = bx0, gw = gw0, NGW = NGW0; asm volatile("" : "+s"(G), "+s"(bx), "+s"(gw), "+s"(NGW))
    const int G0 = gridDim.x, bx0 = blockIdx.x;
    const int gw0 = bx0 * 8 + wid, NGW0 = G0 * 8;
#define MODV ((float*)KWS(WS_MODV))
#define BF(off) ((bf16_t*)KWS(off))

    { unsigned* bw = (unsigned*)KWS(WS_BAR); if (bx0 == 0) for (int i = threadIdx.x; i < XCD_BAR_WORDS; i += 512) bw[i] = 0u;
      if (threadIdx.x < 2) ((volatile LAS unsigned*)(lds + MISC_OFF))[threadIdx.x] = 0u; }
    for (int rep = 0; rep < REP_P0; ++rep) { if (PH & 1) { OPAQUE_GRID(); (void)gw; (void)NGW; p0_prologue(lds, G, bx); } __syncthreads(); }
    grid.sync();
    const XcdBarrier xbar = xcd_barrier_post((unsigned*)KWS(WS_BAR), (volatile LAS unsigned*)(lds + MISC_OFF));
#define GRID_SYNC() xcd_barrier(xbar)
    for (int rep = 0; rep < EXTRA_SYNCS; ++rep) GRID_SYNC();

#pragma unroll 1
    for (int l = 0; l < 2; ++l) {
        if (l == 0) {
            { OPAQUE_LANE(); OPAQUE_GRID(); (void)G; (void)bx; const float* x = KIN(0); const float* modl = MODV; bf16_t* HN = BF(WS_HN); const float* g = KIN(5);
              for (int rep = 0; rep < REP_NORM1; ++rep)
              for (int m = gw; m < T; m += NGW) { const int b = m / SEQ; f32x4 v[4]; const float rstd = row_rstd(x + (size_t)m * DM, lane, v);
                mod_store(v, rstd, g, modl + b * 6144, modl + b * 6144 + 1024, HN + (size_t)m * DM, lane); } }
            GRID_SYNC();
            if (PH & 2) { OPAQUE_GRID(); (void)gw; (void)NGW; pg8::Sched<0> S; S.init(64, 12, 1024, KWS(WS_HN), nullptr, KWS(WS_WQKV), G, bx);
              pg8::EpiBf16 E{BF(WS_R1), DM, DM, (size_t)16 * 1024 * 1024, QS_A};
              for (int rep = 0; rep < REP_QKV; ++rep) run_gemm(lds, 1024, S, E); }
            GRID_SYNC();
            if (PH & 4) { OPAQUE_GRID(); (void)gw; (void)NGW; const bf16_t* R1 = BF(WS_R1); const bf16_t* R2 = BF(WS_R2); const bf16_t* R3 = BF(WS_R3); const float* rb = KIN(9);
              for (int rep = 0; rep < REP_ATTA; ++rep)
              for (int u = bx; u < 1024; u += G) { const int qb = u & 31, bh = u >> 5;
                att::attn_unit<64, true, 1>(lds, bh >> 4, bh & 15, qb * 256, R1, nullptr, R2, nullptr, R3, BF(WS_HN), rb + (bh & 15) * 257); } }
        } else {
            { OPAQUE_LANE(); OPAQUE_GRID(); (void)G; (void)bx; const float* out = KOUT; const float* modl = MODV + 2 * 6144; const float* kvmod = MODV + 24576; bf16_t* HN = BF(WS_HN); bf16_t* HN1 = BF(WS_HN1);
              const float* gkv = KIN(12); const float* g1 = KIN(5) + DM;
              for (int m = gw; m < T; m += NGW) { const int b = m / SEQ; f32x4 v[4]; const float rstd = row_rstd(out + (size_t)m * DM, lane, v);
                mod_store(v, rstd, gkv, kvmod + b * 2048, kvmod + b * 2048 + 1024, HN + (size_t)m * DM, lane);
                mod_store(v, rstd, g1, modl + b * 6144, modl + b * 6144 + 1024, HN1 + (size_t)m * DM, lane); } }
            GRID_SYNC();
            if (PH & 8) { OPAQUE_GRID(); (void)gw; (void)NGW; pg8::Sched<2> S; S.init(64, 4, 1024, KWS(WS_HN), KWS(WS_HN1), KWS(WS_WLD), G, bx);
              pg8::EpiLatDown E{BF(WS_CKV), BF(WS_CQ), BF(WS_KR), (float*)KWS(WS_SSQKV), (float*)KWS(WS_SSQQ), (const float*)KWS(WS_COS), (const float*)KWS(WS_SIN)}; run_gemm(lds, 1024, S, E); }
            GRID_SYNC();
            if (PH & 16) { OPAQUE_GRID(); (void)gw; (void)NGW; pg8::Sched<0> S; S.init(64, 8, KVL, KWS(WS_CKV), nullptr, KWS(WS_WKVUP), G, bx);
              pg8::EpiLatUp<false> E{BF(WS_R2), BF(WS_R3), (const float*)KWS(WS_SSQKV), (const float*)KWS(WS_COS), (const float*)KWS(WS_SIN)}; run_gemm(lds, KVL, S, E); }
            if (PH & 32) { OPAQUE_GRID(); (void)gw; (void)NGW; pg8::Sched<0> S; S.init(64, 6, QL, KWS(WS_CQ), nullptr, KWS(WS_WQUP), G, bx);
              pg8::EpiLatUp<true> E{BF(WS_R1), BF(WS_R4), (const float*)KWS(WS_SSQQ), (const float*)KWS(WS_COS), (const float*)KWS(WS_SIN)}; run_gemm(lds, QL, S, E); }
            GRID_SYNC();
            if (PH & 64) { OPAQUE_GRID(); (void)gw; (void)NGW; const bf16_t* R1 = BF(WS_R1); const bf16_t* R2 = BF(WS_R2); const bf16_t* R3 = BF(WS_R3); const bf16_t* R4 = BF(WS_R4); const bf16_t* KR = BF(WS_KR);
              for (int rep = 0; rep < REP_MLA; ++rep)
              for (int v0 = bx; v0 < 256; v0 += G) { const int vcu = (G == 256) ? (v0 % 8) * 32 + v0 / 8 : v0; const int bh = vcu >> 3, s = vcu & 7;
#pragma unroll 1
                for (int i = 0; i < 2; ++i) { const int qb = (i == 0) ? s : 15 - s;
                    att::attn_unit<96, false, 2>(lds, bh >> 4, bh & 15, qb * 512, R1, R4, R2, KR, R3, BF(WS_HN), nullptr); } } }
        }
        GRID_SYNC();
        if (PH & 128) { OPAQUE_GRID(); (void)gw; (void)NGW; pg8::Sched<0> S; S.init(64, 4, 1024, KWS(WS_HN), nullptr, KWS(l == 0 ? WS_WO : WS_BWO), G, bx);
          pg8::EpiRes E{l == 0 ? KIN(0) : (const float*)KOUT, KOUT, MODV + (size_t)l * 2 * 6144 + 2048}; run_gemm(lds, 1024, S, E); }
        GRID_SYNC();
        { OPAQUE_LANE(); OPAQUE_GRID(); (void)G; (void)bx; const float* out = KOUT; const float* modl = MODV + (size_t)l * 2 * 6144; bf16_t* HN = BF(WS_HN); const float* g = KIN(6) + l * DM;
          for (int m = gw; m < T; m += NGW) { const int b = m / SEQ, s = m % SEQ; f32x4 v[4]; const float rstd = row_rstd(out + (size_t)m * DM, lane, v);
            mod_store(v, rstd, g, modl + b * 6144 + 3072, modl + b * 6144 + 4096, HN + ((size_t)b * PADROWS + 2 + s) * DM, lane); }
          if (gw < 4) { bf16_t* z = HN + ((size_t)(gw >> 1) * PADROWS + (gw & 1)) * DM;
#pragma unroll
            for (int j = 0; j < 4; ++j) ((u32x2*)z)[64 * j + lane] = (u32x2){0u, 0u}; } }
        GRID_SYNC();
        if (PH & 256) { OPAQUE_GRID(); (void)gw; (void)NGW; pg8::Sched<1> S; S.init(2 * FT, 22, 1024, KWS(WS_HN), nullptr, KWS(WS_WIN + (size_t)l * FFN2 * 1024 * 2), G, bx);
          pg8::EpiConv E{KIN(24) + (size_t)l * 3 * FFN2, KIN(25) + (size_t)l * FFN2, BF(WS_ACT)};
          for (int rep = 0; rep < REP_FFNIN; ++rep) run_gemm(lds, 1024, S, E); }
        GRID_SYNC();
        if (PH & 512) { OPAQUE_GRID(); (void)gw; (void)NGW; pg8::Sched<0> S; S.init(64, 4, FFN, KWS(WS_ACT), nullptr, KWS(WS_WOUT + (size_t)l * 1024 * FFN * 2), G, bx);
          pg8::EpiRes E{KOUT, KOUT, MODV + (size_t)l * 2 * 6144 + 5120}; run_gemm(lds, FFN, S, E); }
        GRID_SYNC();
    }
    { OPAQUE_LANE(); OPAQUE_GRID(); (void)G; (void)bx; float* out = KOUT; const f32x4* fg = (const f32x4*)karg(27);
      for (int m = gw; m < T; m += NGW) { f32x4 v[4]; const float rstd = row_rstd(out + (size_t)m * DM, lane, v);
#pragma unroll
        for (int j = 0; j < 4; ++j) { const f32x4 gg = fg[64 * j + lane]; ((f32x4*)(out + (size_t)m * DM))[64 * j + lane] = v[j] * rstd * gg; } } }
}

extern "C" void kernel_launch(void* const* d_in, const int* in_sizes, int n_in, void* d_out, int out_size, void* d_ws, size_t ws_size, hipStream_t stream) {
    static int grid_blocks = 0;
    if (grid_blocks == 0) {
        if (n_in != 28 || out_size != T * DM || ws_size < WS_END) { fprintf(stderr, "kernel_launch: unexpected problem (n_in %d out %d ws %zu)\n", n_in, out_size, ws_size); grid_blocks = -1; return; }
        int dev = 0, cus = 0, per_cu = 0;
        hipGetDevice(&dev); hipDeviceGetAttribute(&cus, hipDeviceAttributeMultiprocessorCount, dev);
        if (hipFuncSetAttribute((const void*)fwd_megakernel, hipFuncAttributeMaxDynamicSharedMemorySize, LDS_BYTES) != hipSuccess) { fprintf(stderr, "kernel_launch: hipFuncSetAttribute failed\n"); grid_blocks = -1; return; }
        if (hipOccupancyMaxActiveBlocksPerMultiprocessor(&per_cu, (const void*)fwd_megakernel, 512, LDS_BYTES) != hipSuccess || per_cu < 1) { fprintf(stderr, "kernel_launch: occupancy query says %d\n", per_cu); per_cu = 1; (void)hipGetLastError(); }
        grid_blocks = cus * per_cu;
        if (grid_blocks > 256) grid_blocks = 256;
    }
    if (grid_blocks < 0) return;
    Params p{};
    for (int i = 0; i < 28; ++i) p.in[i] = d_in[i];
    p.out = (float*)d_out; p.ws = (unsigned char*)d_ws;
    void* args[] = {&p};
    hipError_t e = hipLaunchCooperativeKernel((const void*)fwd_megakernel, dim3(grid_blocks), dim3(512), args, LDS_BYTES, stream);
    if (e != hipSuccess) fprintf(stderr, "cooperative launch failed: %s (grid %d)\n", hipGetErrorString(e), grid_blocks);
}
```

```cpp
#include <hip/hip_runtime.h>
#include <hip/hip_cooperative_groups.h>
#include <cstdio>
#include <cstdint>
#ifndef REP_MLA
#define REP_MLA 1
#endif
#ifndef REP_ATTA
#define REP_ATTA 1
#endif
#ifndef REP_FFNIN
#define REP_FFNIN 1
#endif
#ifndef REP_QKV
#define REP_QKV 1
#endif
#ifndef REP_P0
#define REP_P0 1
#endif
#ifndef EXTRA_SYNCS
#define EXTRA_SYNCS 0
#endif
#ifndef REP_NORM1
#define REP_NORM1 1
#endif
#ifndef REP_FFNOUT_L0
#define REP_FFNOUT_L0 0
#endif
#ifndef PH
#define PH 0xFFFF
#endif
namespace cg = cooperative_groups;

#define LAS __attribute__((address_space(3)))
typedef unsigned short bf16_t;
typedef short bf16x8 __attribute__((ext_vector_type(8)));
typedef short s16x4 __attribute__((ext_vector_type(4)));
typedef float f32x2 __attribute__((ext_vector_type(2)));
typedef float f32x4 __attribute__((ext_vector_type(4)));
typedef float f32x16 __attribute__((ext_vector_type(16)));
typedef unsigned u32x2 __attribute__((ext_vector_type(2)));
typedef unsigned u32x4 __attribute__((ext_vector_type(4)));

constexpr int BATCH = 2, SEQ = 8192, DM = 1024, T = BATCH * SEQ, FFN = 2816, FFN2 = 5632;
constexpr int NH = 16, KVL = 256, QL = 384, ROPE = 32;
constexpr int PADROWS = 8448, FT = 33;
constexpr float EPS = 1e-6f;
constexpr float LOG2E = 1.4426950408889634f;
constexpr float QS_A = 0.125f * LOG2E;
constexpr float QS_B = 0.10206207261596577f * LOG2E;

constexpr size_t MiB = 1u << 20;
constexpr size_t WS_MODV = 0;
constexpr size_t WS_SSQKV = 256 * 1024;
constexpr size_t WS_SSQQ = 512 * 1024;
constexpr size_t WS_COS = 1 * MiB, WS_SIN = 2 * MiB;
constexpr size_t WS_BAR = 3 * MiB;
constexpr size_t WS_WQKV = 4 * MiB;
constexpr size_t WS_WO = 10 * MiB;
constexpr size_t WS_WIN = 12 * MiB;
constexpr size_t WS_WOUT = 34 * MiB;
constexpr size_t WS_WLD = 45 * MiB;
constexpr size_t WS_WKVUP = 47 * MiB;
constexpr size_t WS_WQUP = 48 * MiB;
constexpr size_t WS_BWO = 50 * MiB;
constexpr size_t WS_HN = 52 * MiB;
constexpr size_t WS_R1 = 86 * MiB;
constexpr size_t WS_R2 = 118 * MiB;
constexpr size_t WS_R3 = 150 * MiB;
constexpr size_t WS_R4 = 182 * MiB;
constexpr size_t WS_ACT = 86 * MiB;
constexpr size_t WS_HN1 = 198 * MiB;
constexpr size_t WS_CKV = 230 * MiB;
constexpr size_t WS_CQ = 238 * MiB;
constexpr size_t WS_KR = 250 * MiB;
constexpr size_t WS_END = 251 * MiB;

constexpr int RING_BYTES = 131072;
constexpr int XCH_OFF = RING_BYTES;
constexpr int MISC_OFF = XCH_OFF + 8192;
constexpr int LDS_BYTES = 147456;

__device__ __forceinline__ unsigned cvt_pk_bf16(float lo, float hi) { unsigned r; asm volatile("v_cvt_pk_bf16_f32 %0, %1, %2" : "=v"(r) : "v"(lo), "v"(hi)); return r; }
__device__ __forceinline__ float lane_read(float v, int src_lane) { return __builtin_bit_cast(float, __builtin_amdgcn_ds_bpermute(src_lane << 2, __builtin_bit_cast(int, v))); }
__device__ __forceinline__ float wave_sum(float v, int lane) {
#pragma unroll
    for (int o = 1; o < 64; o <<= 1) v += lane_read(v, lane ^ o);
    return v;
}

namespace pg8 {
#define PG8_LAS __attribute__((address_space(3)))
constexpr int BM = 256, BK = 64, HALF = 128, HTB = HALF * BK * 2, STAGE_BYTES = 8 * HTB, NXCD = 8, WGM = 8;
__host__ __device__ __forceinline__ int lds_byte(int r, int c) { const int st = (r >> 4) * 2 + (c >> 5), rr = r & 15, cc = c & 31, ob = rr * 64 + cc * 2; return st * 1024 + (ob ^ (((ob >> 9) & 1) << 5)); }
__host__ __device__ __forceinline__ void stage_rc(int b, int& R, int& C) { const int st = b / 1024, sb = b % 1024, swz = sb ^ (((sb >> 9) & 1) << 5); R = (st >> 1) * 16 + swz / 64; C = (st & 1) * 32 + (swz % 64) / 2; }
__host__ __device__ __forceinline__ int perm32(int rho) { const int n = rho >> 4, i = rho & 15; return 8 * (i >> 2) + 4 * n + (i & 3); }
struct Unit { int pm, pn; };

template <int MODE> struct Sched {
    int nM, nN, nwg, G, c, K; const char* A0; const char* A1; const char* B;
    __device__ void init(int nM_, int nN_, int K_, const void* a0, const void* a1, const void* b, int G_, int c_) { nM = nM_; nN = nN_; nwg = nM * nN; K = K_; A0 = (const char*)a0; A1 = (const char*)a1; B = (const char*)b; G = G_; c = c_; }
    __device__ bool next(int i, Unit& u) const {
        const long L = (long)i * G + c; if (L >= nwg) return false;
        int wgid = (int)L; { const int q = nwg / NXCD, r = nwg % NXCD, xcd = wgid % NXCD, off = wgid / NXCD; wgid = (xcd < r ? xcd * (q + 1) : r * (q + 1) + (xcd - r) * q) + off; }
        const int nig = WGM * nN, gid = wgid / nig, fm = gid * WGM, gsz = (nM - fm) < WGM ? (nM - fm) : WGM;
        u.pm = fm + ((wgid % nig) % gsz); u.pn = (wgid % nig) / gsz; return true;
    }
    __device__ __forceinline__ const char* abase(const Unit& u) const {
        if (MODE == 1) { const int b = u.pm / FT, i = u.pm % FT; return A0 + ((size_t)b * PADROWS + (size_t)254 * i) * (size_t)K * 2; }
        if (MODE == 2) return (u.pn < 2 ? A0 : A1) + (size_t)u.pm * 256 * K * 2;
        return A0 + (size_t)u.pm * 256 * K * 2;
    }
    __device__ __forceinline__ const char* bbase(const Unit& u) const { return B + (size_t)u.pn * 256 * K * 2; }
};
typedef const f32x4 (&AccRef)[2][2][4][2];

struct EpiBf16 {
    static constexpr bool PERM = true;
    bf16_t* O; int ldc; int split_cols; size_t split_stride; float scale0;
    __device__ __forceinline__ void operator()(AccRef acc, const Unit& u, int wr, int wc, int fr_in, int fq_in, PG8_LAS unsigned char*) const {
        int fr = fr_in, fq = fq_in; asm volatile("" : "+v"(fr), "+v"(fq));
        const int row0 = u.pm * BM + wr * 64 + fr; int colt = u.pn * BM; bf16_t* base = O;
        float sc = 1.f; if (split_cols) { const int t = colt / split_cols; base += (size_t)t * split_stride; colt -= t * split_cols; if (t == 0) sc = scale0; }
        const int col0 = colt + wc * 32 + 8 * fq;
#pragma unroll
        for (int ai = 0; ai < 2; ++ai)
#pragma unroll
            for (int m = 0; m < 4; ++m) { bf16_t* rowp = base + (size_t)(row0 + ai * HALF + m * 16) * ldc + col0;
#pragma unroll
                for (int bj = 0; bj < 2; ++bj) { f32x4 v0 = acc[ai][bj][m][0] * sc, v1 = acc[ai][bj][m][1] * sc;
                    u32x4 w; w.x = cvt_pk_bf16(v0[0], v0[1]); w.y = cvt_pk_bf16(v0[2], v0[3]); w.z = cvt_pk_bf16(v1[0], v1[1]); w.w = cvt_pk_bf16(v1[2], v1[3]);
                    *(u32x4*)(rowp + bj * HALF) = w; } }
    }
};
struct EpiRes {
    static constexpr bool PERM = false;
    const float* hin; float* hout; const float* gate;
    __device__ __forceinline__ void operator()(AccRef acc, const Unit& u, int wr, int wc, int fr_in, int fq_in, PG8_LAS unsigned char*) const {
        int fr = fr_in, fq = fq_in; asm volatile("" : "+v"(fr), "+v"(fq));
        const int row0 = u.pm * BM + wr * 64 + fr, col0 = u.pn * BM + wc * 32 + 4 * fq, b = (u.pm * BM) / SEQ;
        const float* gp = gate + (size_t)b * 6144 + col0;
        f32x4 gv[2][2];
#pragma unroll
        for (int bj = 0; bj < 2; ++bj)
#pragma unroll
            for (int n = 0; n < 2; ++n) gv[bj][n] = *(const f32x4*)(gp + bj * HALF + n * 16);
#pragma unroll
        for (int ai = 0; ai < 2; ++ai)
#pragma unroll
            for (int m = 0; m < 4; ++m) { const size_t off = (size_t)(row0 + ai * HALF + m * 16) * DM + col0;
#pragma unroll
                for (int bj = 0; bj < 2; ++bj)
#pragma unroll
                    for (int n = 0; n < 2; ++n) { const f32x4 bs = *(const f32x4*)(hin + off + bj * HALF + n * 16);
                        *(f32x4*)(hout + off + bj * HALF + n * 16) = bs + gv[bj][n] * acc[ai][bj][m][n]; }
                if (m & 1) asm volatile("" ::: "memory"); }
    }
};
struct EpiConv {
    static constexpr bool PERM = true;
    const float* cw; const float* cb; bf16_t* act;
    __device__ __forceinline__ void operator()(AccRef acc, const Unit& u, int wr, int wc, int fr_in, int fq_in, PG8_LAS unsigned char* lds) const {
        int fr = fr_in, fq = fq_in; asm volatile("" : "+v"(fr), "+v"(fq));
        PG8_LAS f32x4* X = (PG8_LAS f32x4*)(lds + XCH_OFF);
        const int lane = fr + 16 * fq;
        if (fr >= 14) {
#pragma unroll
            for (int ai = 0; ai < 2; ++ai)
#pragma unroll
                for (int bj = 0; bj < 2; ++bj)
#pragma unroll
                    for (int n = 0; n < 2; ++n) X[((((((ai * 2 + wr) * 2 + (fr - 14)) * 4 + wc) * 2 + bj) * 2 + n) * 4) + fq] = acc[ai][bj][3][n];
        }
        asm volatile("s_waitcnt lgkmcnt(0)" ::: "memory"); __builtin_amdgcn_s_barrier(); asm volatile("" ::: "memory");
        const int b = u.pm / FT, it = u.pm % FT;
        const int src1 = (lane & 48) | ((lane - 1) & 15), src2 = (lane & 48) | ((lane - 2) & 15);
#pragma unroll
        for (int n = 0; n < 2; ++n) {
            const int gc = 128 * u.pn + 32 * wc + 8 * fq + 4 * n;
            const f32x4 wg0 = *(const f32x4*)(cw + gc), wg1 = *(const f32x4*)(cw + FFN2 + gc), wg2 = *(const f32x4*)(cw + 2 * FFN2 + gc), bg = *(const f32x4*)(cb + gc);
            const f32x4 wv0 = *(const f32x4*)(cw + FFN + gc), wv1 = *(const f32x4*)(cw + FFN2 + FFN + gc), wv2 = *(const f32x4*)(cw + 2 * FFN2 + FFN + gc), bv = *(const f32x4*)(cb + FFN + gc);
#pragma unroll
            for (int ai = 0; ai < 2; ++ai) {
                const int G = ai * 2 + wr;
                f32x4 pg = (f32x4){0.f, 0.f, 0.f, 0.f}, pv = pg;
                if (G > 0) {
                    const int rr = (fr == 15) ? 1 : 0;
                    pg = X[((((((G - 1) * 2 + rr) * 4 + wc) * 2 + 0) * 2 + n) * 4) + fq];
                    pv = X[((((((G - 1) * 2 + rr) * 4 + wc) * 2 + 1) * 2 + n) * 4) + fq];
                }
#pragma unroll
                for (int m = 0; m < 4; ++m) {
                    const f32x4 cg = acc[ai][0][m][n], cv = acc[ai][1][m][n];
                    const f32x4 qg = (m == 0) ? pg : acc[ai][0][m > 0 ? m - 1 : 0][n], qv = (m == 0) ? pv : acc[ai][1][m > 0 ? m - 1 : 0][n];
                    float o[4];
#pragma unroll
                    for (int e = 0; e < 4; ++e) {
                        const float g1c = lane_read(cg[e], src1), g1p = lane_read(qg[e], src1), g2c = lane_read(cg[e], src2), g2p = lane_read(qg[e], src2);
                        const float v1c = lane_read(cv[e], src1), v1p = lane_read(qv[e], src1), v2c = lane_read(cv[e], src2), v2p = lane_read(qv[e], src2);
                        const float g1 = fr >= 1 ? g1c : g1p, g2 = fr >= 2 ? g2c : g2p, v1 = fr >= 1 ? v1c : v1p, v2 = fr >= 2 ? v2c : v2p;
                        const float yg = bg[e] + wg0[e] * g2 + wg1[e] * g1 + wg2[e] * cg[e];
                        const float yv = bv[e] + wv0[e] * v2 + wv1[e] * v1 + wv2[e] * cv[e];
                        const float sg = yg * __builtin_amdgcn_rcpf(1.0f + __builtin_amdgcn_exp2f(-yg * LOG2E));
                        o[e] = sg * yv;
                    }
                    const int R = ai * HALF + wr * 64 + m * 16 + fr, tok = 254 * it - 2 + R;
                    if (R >= 2 && tok < SEQ) { u32x2 w; w.x = cvt_pk_bf16(o[0], o[1]); w.y = cvt_pk_bf16(o[2], o[3]);
                        *(u32x2*)(act + ((size_t)b * SEQ + tok) * FFN + gc) = w; }
                }
            }
        }
    }
};
struct EpiLatDown {
    static constexpr bool PERM = false;
    bf16_t* ckv; bf16_t* cq; bf16_t* kr; float* ssqkv; float* ssqq; const float* cosT; const float* sinT;
    __device__ __forceinline__ void operator()(AccRef acc, const Unit& u, int wr, int wc, int fr_in, int fq_in, PG8_LAS unsigned char*) const {
        int fr = fr_in, fq = fq_in; asm volatile("" : "+v"(fr), "+v"(fq));
        const int row0 = u.pm * BM + wr * 64 + fr, cl = wc * 32 + 4 * fq;
        if (u.pn == 1) {
            if (wc == 0) {
#pragma unroll
                for (int ai = 0; ai < 2; ++ai)
#pragma unroll
                    for (int m = 0; m < 4; ++m) { const int row = row0 + ai * HALF + m * 16;
                        const f32x4 c = *(const f32x4*)(cosT + (size_t)row * 16 + 4 * fq), s = *(const f32x4*)(sinT + (size_t)row * 16 + 4 * fq);
                        const f32x4 t1 = acc[ai][0][m][0], t2 = acc[ai][0][m][1];
                        const f32x4 o1 = t1 * c - t2 * s, o2 = t2 * c + t1 * s;
                        u32x2 w1, w2; w1.x = cvt_pk_bf16(o1[0], o1[1]); w1.y = cvt_pk_bf16(o1[2], o1[3]); w2.x = cvt_pk_bf16(o2[0], o2[1]); w2.y = cvt_pk_bf16(o2[2], o2[3]);
                        *(u32x2*)(kr + (size_t)row * ROPE + 4 * fq) = w1; *(u32x2*)(kr + (size_t)row * ROPE + 16 + 4 * fq) = w2; }
            }
            return;
        }
        const bool isq = u.pn >= 2; const int cbase = isq ? (u.pn - 2) * 256 : 0, ld = isq ? QL : KVL; bf16_t* O = isq ? cq : ckv;
#pragma unroll
        for (int ai = 0; ai < 2; ++ai)
#pragma unroll
            for (int m = 0; m < 4; ++m) { const int row = row0 + ai * HALF + m * 16; float ss = 0.f;
#pragma unroll
                for (int bj = 0; bj < 2; ++bj)
#pragma unroll
                    for (int n = 0; n < 2; ++n) { const f32x4 v = acc[ai][bj][m][n]; ss += (v[0] * v[0] + v[1] * v[1]) + (v[2] * v[2] + v[3] * v[3]);
                        const int c = cbase + bj * HALF + cl + n * 16;
                        if (c < ld) { u32x2 w; w.x = cvt_pk_bf16(v[0], v[1]); w.y = cvt_pk_bf16(v[2], v[3]); *(u32x2*)(O + (size_t)row * ld + c) = w; } }
                ss += lane_read(ss, (fr + 16 * fq) ^ 16); ss += lane_read(ss, (fr + 16 * fq) ^ 32);
                if (fq == 0) { if (isq) ssqq[(size_t)row * 8 + (u.pn - 2) * 4 + wc] = ss; else ssqkv[(size_t)row * 4 + wc] = ss; } }
    }
};
template <bool ISQ> struct EpiLatUp {
    static constexpr bool PERM = false;
    bf16_t* O0; bf16_t* O1; const float* ssq; const float* cosT; const float* sinT;
    __device__ __forceinline__ void operator()(AccRef acc, const Unit& u, int wr, int wc, int fr_in, int fq_in, PG8_LAS unsigned char*) const {
        int fr = fr_in, fq = fq_in; asm volatile("" : "+v"(fr), "+v"(fq));
        const int row0 = u.pm * BM + wr * 64 + fr, cl = wc * 32 + 4 * fq;
        const bool second = u.pn >= 4; const int ct = (second ? u.pn - 4 : u.pn) * 256; bf16_t* O = second ? O1 : O0; constexpr int ld = DM;
#pragma unroll
        for (int ai = 0; ai < 2; ++ai)
#pragma unroll
            for (int m = 0; m < 4; ++m) { const int row = row0 + ai * HALF + m * 16; float rs;
                if (ISQ) { const f32x4 a = *(const f32x4*)(ssq + (size_t)row * 8), b2 = *(const f32x4*)(ssq + (size_t)row * 8 + 4);
                    rs = __builtin_amdgcn_rsqf((((a[0] + a[1]) + (a[2] + a[3])) + ((b2[0] + b2[1]) + (b2[2] + b2[3]))) * (1.0f / QL) + EPS) * QS_B; }
                else { const f32x4 a = *(const f32x4*)(ssq + (size_t)row * 4); rs = __builtin_amdgcn_rsqf(((a[0] + a[1]) + (a[2] + a[3])) * (1.0f / KVL) + EPS); }
                asm volatile("" : "+v"(rs) :: "memory");
                if (ISQ && second) {
                    const f32x4 c = *(const f32x4*)(cosT + (size_t)row * 16 + 4 * fq), s = *(const f32x4*)(sinT + (size_t)row * 16 + 4 * fq);
#pragma unroll
                    for (int bj = 0; bj < 2; ++bj) { const f32x4 t1 = acc[ai][bj][m][0] * rs, t2 = acc[ai][bj][m][1] * rs;
                        const f32x4 o1 = t1 * c - t2 * s, o2 = t2 * c + t1 * s;
                        u32x2 w1, w2; w1.x = cvt_pk_bf16(o1[0], o1[1]); w1.y = cvt_pk_bf16(o1[2], o1[3]); w2.x = cvt_pk_bf16(o2[0], o2[1]); w2.y = cvt_pk_bf16(o2[2], o2[3]);
                        bf16_t* p = O + (size_t)row * ld + ct + bj * HALF + cl; *(u32x2*)p = w1; *(u32x2*)(p + 16) = w2; asm volatile("" ::: "memory"); }
                } else {
#pragma unroll
                    for (int bj = 0; bj < 2; ++bj)
#pragma unroll
                        for (int n = 0; n < 2; ++n) { const f32x4 v = acc[ai][bj][m][n] * rs; u32x2 w; w.x = cvt_pk_bf16(v[0], v[1]); w.y = cvt_pk_bf16(v[2], v[3]);
                            *(u32x2*)(O + (size_t)row * ld + ct + bj * HALF + cl + n * 16) = w; }
                }
                asm volatile("" ::: "memory"); }
    }
};
template <class Epi, class Sched, bool ALIGN_EPI = false, bool SP2 = false>
__device__ __forceinline__ void gemm_phase(PG8_LAS unsigned char* lds, const int K, const Sched& S, const Epi& E) {
    int tid_ = threadIdx.x; asm volatile("" : "+v"(tid_));
    const int tid = tid_, wid = __builtin_amdgcn_readfirstlane(tid >> 6), lane = tid & 63, wr = wid >> 2, wc = wid & 3, fr = lane & 15, fq = lane >> 4;
    const int nt = K / BK;
    unsigned voffA[2], voffB[2];
#pragma unroll
    for (int i = 0; i < 2; ++i) { int R, C; stage_rc(tid * 16 + i * 8192, R, C); const int Rb = Epi::PERM ? ((R & ~31) + perm32(R & 31)) : R;
        voffA[i] = (unsigned)(R * K + C) * 2u; voffB[i] = (unsigned)(Rb * K + C) * 2u; }
    const size_t kstep = (size_t)(BK * 2);
    const size_t hstep = (size_t)HALF * K * 2;
    const unsigned ldsw = (unsigned)wid * 1024u;
    const int aoff = lds_byte(wr * 64 + fr, fq * 8), boff = lds_byte(wc * 32 + fr, fq * 8);
#define PG8_SA(b, h) (((b) * 2 + (h)) * HTB)
#define PG8_SB(b, h) ((4 + (b) * 2 + (h)) * HTB)
#define PG8_STAGE(bufoff, gbase, voff) do { _Pragma("unroll") for (int _i = 0; _i < 2; ++_i) \
        __builtin_amdgcn_global_load_lds((const unsigned*)((const char*)(gbase) + (voff)[_i]), (PG8_LAS unsigned*)(lds + (bufoff) + ldsw + _i * 8192), 16, 0, 0); } while (0)
#define PG8_LDA(dst, b, h) do { _Pragma("unroll") for (int m = 0; m < 4; ++m) _Pragma("unroll") for (int k = 0; k < 2; ++k) dst[m][k] = *(const PG8_LAS bf16x8*)(lds + PG8_SA(b, h) + aoff + m * 2048 + k * 1024); } while (0)
#define PG8_LDB(dst, b, h) do { _Pragma("unroll") for (int n = 0; n < 2; ++n) _Pragma("unroll") for (int k = 0; k < 2; ++k) dst[n][k] = *(const PG8_LAS bf16x8*)(lds + PG8_SB(b, h) + boff + n * 2048 + k * 1024); } while (0)
#define PG8_MMA(ai, bj, At, Bt) do { __builtin_amdgcn_s_setprio(1); _Pragma("unroll") for (int m = 0; m < 4; ++m) _Pragma("unroll") for (int n = 0; n < 2; ++n) _Pragma("unroll") for (int k = 0; k < 2; ++k) \
        acc[ai][bj][m][n] = __builtin_amdgcn_mfma_f32_16x16x32_bf16(Bt[n][k], At[m][k], acc[ai][bj][m][n], 0, 0, 0); __builtin_amdgcn_s_setprio(0); } while (0)
#define PG8_WAIT_V(n) asm volatile("s_waitcnt vmcnt(" #n ")" ::: "memory")
#define PG8_WAIT_L(n) asm volatile("s_waitcnt lgkmcnt(" #n ")" ::: "memory")
#define PG8_BAR __builtin_amdgcn_s_barrier()
#define PG8_SCHED __builtin_amdgcn_sched_barrier(0)
    Unit cur, nxt; int ui = 0;
    if (!S.next(0, cur)) return;
    f32x4 acc[2][2][4][2];
#pragma unroll
    for (int a = 0; a < 2; ++a)
#pragma unroll
        for (int b = 0; b < 2; ++b)
#pragma unroll
            for (int m = 0; m < 4; ++m)
#pragma unroll
                for (int n = 0; n < 2; ++n) acc[a][b][m][n] = (f32x4){0.f, 0.f, 0.f, 0.f};
    bf16x8 At[4][2], B0[2][2], B1[2][2];
    const char* cA = S.abase(cur); const char* cB = S.bbase(cur);
    if constexpr (SP2) {
        PG8_STAGE(PG8_SB(0, 0), cB, voffB); PG8_STAGE(PG8_SB(0, 1), cB + hstep, voffB); PG8_STAGE(PG8_SA(0, 0), cA, voffA); PG8_STAGE(PG8_SA(0, 1), cA + hstep, voffA);
        if (wr == 1) PG8_BAR;
        PG8_WAIT_V(2); PG8_BAR;
        PG8_STAGE(PG8_SB(1, 0), cB + kstep, voffB); PG8_STAGE(PG8_SA(1, 0), cA + kstep, voffA); PG8_STAGE(PG8_SB(1, 1), cB + hstep + kstep, voffB);
        PG8_WAIT_V(6); PG8_BAR;
    } else {
        PG8_STAGE(PG8_SB(0, 0), cB, voffB); PG8_STAGE(PG8_SA(0, 0), cA, voffA); PG8_STAGE(PG8_SB(0, 1), cB + hstep, voffB); PG8_STAGE(PG8_SA(0, 1), cA + hstep, voffA);
        if (wr == 1) PG8_BAR;
        PG8_WAIT_V(4); PG8_BAR;
        PG8_STAGE(PG8_SB(1, 0), cB + kstep, voffB); PG8_STAGE(PG8_SA(1, 0), cA + kstep, voffA); PG8_STAGE(PG8_SB(1, 1), cB + hstep + kstep, voffB);
        PG8_WAIT_V(6); PG8_BAR;
    }
    for (;;) {
        const bool has_next = S.next(ui + 1, nxt);
        const char* nA = has_next ? S.abase(nxt) : cA; const char* nB = has_next ? S.bbase(nxt) : cB;
        for (int t = 0; t < nt; t += 2) {
            const bool last = (t == nt - 2);
            const char* a1 = cA + (size_t)(t + 1) * kstep;
            const char* a2 = last ? nA : cA + (size_t)(t + 2) * kstep; const char* b2 = last ? nB : cB + (size_t)(t + 2) * kstep;
            const char* a3 = a2 + kstep; const char* b3 = b2 + kstep;
            if constexpr (SP2) {
            PG8_LDB(B0, 0, 0); PG8_LDB(B1, 0, 1); PG8_SCHED; PG8_LDA(At, 0, 0); PG8_STAGE(PG8_SA(1, 1), a1 + hstep, voffA);
            PG8_WAIT_V(8); PG8_WAIT_L(0); PG8_BAR; PG8_MMA(0, 0, At, B0); PG8_MMA(0, 1, At, B1); PG8_BAR; PG8_SCHED;
            PG8_LDA(At, 0, 1); PG8_STAGE(PG8_SB(0, 0), b2, voffB); PG8_STAGE(PG8_SB(0, 1), b2 + hstep, voffB); PG8_STAGE(PG8_SA(0, 0), a2, voffA);
            PG8_WAIT_V(8); PG8_WAIT_L(0); PG8_BAR; PG8_MMA(1, 0, At, B0); PG8_MMA(1, 1, At, B1); PG8_BAR; PG8_SCHED;
            PG8_LDB(B0, 1, 0); PG8_LDB(B1, 1, 1); PG8_SCHED; PG8_LDA(At, 1, 0); PG8_STAGE(PG8_SA(0, 1), a2 + hstep, voffA);
            PG8_WAIT_V(8); PG8_WAIT_L(0); PG8_BAR; PG8_MMA(0, 0, At, B0); PG8_MMA(0, 1, At, B1); PG8_BAR; PG8_SCHED;
            PG8_LDA(At, 1, 1); PG8_STAGE(PG8_SB(1, 0), b3, voffB); PG8_STAGE(PG8_SB(1, 1), b3 + hstep, voffB); PG8_STAGE(PG8_SA(1, 0), a3, voffA);
            PG8_WAIT_V(8); PG8_WAIT_L(0); PG8_BAR; PG8_MMA(1, 0, At, B0); PG8_MMA(1, 1, At, B1); PG8_BAR; PG8_SCHED;
            } else {
            PG8_LDB(B0, 0, 0); PG8_SCHED; PG8_LDA(At, 0, 0); PG8_STAGE(PG8_SA(1, 1), a1 + hstep, voffA);
            PG8_WAIT_L(8); PG8_BAR; PG8_WAIT_L(0); PG8_MMA(0, 0, At, B0); PG8_BAR; PG8_SCHED;
            PG8_LDB(B1, 0, 1); PG8_STAGE(PG8_SB(0, 0), b2, voffB);
            PG8_BAR; PG8_WAIT_L(0); PG8_MMA(0, 1, At, B1); PG8_BAR;
            PG8_LDA(At, 0, 1); PG8_STAGE(PG8_SA(0, 0), a2, voffA);
            PG8_BAR; PG8_WAIT_L(0); PG8_MMA(1, 0, At, B0); PG8_BAR; PG8_SCHED;
            PG8_STAGE(PG8_SB(0, 1), b2 + hstep, voffB);
            PG8_WAIT_V(6); PG8_BAR; PG8_MMA(1, 1, At, B1); PG8_BAR;
            PG8_LDB(B0, 1, 0); PG8_SCHED; PG8_LDA(At, 1, 0); PG8_STAGE(PG8_SA(0, 1), a2 + hstep, voffA);
            PG8_WAIT_L(8); PG8_BAR; PG8_WAIT_L(0); PG8_MMA(0, 0, At, B0); PG8_BAR; PG8_SCHED;
            PG8_LDB(B1, 1, 1); PG8_STAGE(PG8_SB(1, 0), b3, voffB);
            PG8_BAR; PG8_WAIT_L(0); PG8_MMA(0, 1, At, B1); PG8_BAR;
            PG8_LDA(At, 1, 1); PG8_STAGE(PG8_SA(1, 0), a3, voffA);
            PG8_BAR; PG8_WAIT_L(0); PG8_MMA(1, 0, At, B0); PG8_BAR; PG8_SCHED;
            PG8_STAGE(PG8_SB(1, 1), b3 + hstep, voffB);
            PG8_WAIT_V(6); PG8_BAR; PG8_MMA(1, 1, At, B1); PG8_BAR;
            }
        }
        if constexpr (ALIGN_EPI) { if (wr == 0) PG8_BAR; }
        E(acc, cur, wr, wc, fr, fq, lds);
        if (!has_next) break;
#pragma unroll
        for (int a = 0; a < 2; ++a)
#pragma unroll
            for (int b = 0; b < 2; ++b)
#pragma unroll
                for (int m = 0; m < 4; ++m)
#pragma unroll
                    for (int n = 0; n < 2; ++n) acc[a][b][m][n] = (f32x4){0.f, 0.f, 0.f, 0.f};
        cur = nxt; cA = nA; cB = nB; ++ui;
        if constexpr (ALIGN_EPI) { if (wr == 1) PG8_BAR; }
    }
    PG8_WAIT_V(0);
    if constexpr (!ALIGN_EPI) { if (wr == 0) PG8_BAR; }
    PG8_BAR;
#undef PG8_SA
#undef PG8_SB
#undef PG8_STAGE
#undef PG8_LDA
#undef PG8_LDB
#undef PG8_MMA
#undef PG8_WAIT_V
#undef PG8_WAIT_L
#undef PG8_BAR
#undef PG8_SCHED
}
}
namespace att {
__device__ __forceinline__ int crow(int r, int hi) { return (r & 3) + 8 * (r >> 2) + 4 * hi; }
typedef short v4i16_t __attribute__((ext_vector_type(4)));
__device__ __forceinline__ s16x4 vtr(const LAS unsigned char* p) { return __builtin_bit_cast(s16x4, __builtin_amdgcn_ds_read_tr16_b64_v4i16((LAS v4i16_t*)p)); }
#define MFMA32(a, b, c) __builtin_amdgcn_mfma_f32_32x32x16_bf16((a), (b), (c), 0, 0, 0)

template <int DQK, bool BIAS, int NB>
__device__ __forceinline__ void attn_unit(LAS unsigned char* lds, int b, int h, int q0, const bf16_t* Qn, const bf16_t* Qr, const bf16_t* Kn, const bf16_t* Kr,
                                          const bf16_t* Vg, bf16_t* Og, const float* biasg) {
    constexpr int NC = DQK / 8, KSZ = NC * 1024, ND = DQK / 16;
    constexpr int OFF_V = 2 * KSZ, OFF_WSF = OFF_V + 16384, OFF_BT = OFF_WSF + 8 * 64 * NB * 4;
    int tid_ = threadIdx.x; asm volatile("" : "+v"(tid_));
    const int tid = tid_, lane = tid & 63, r32 = lane & 31, hi = lane >> 5; const int wid = __builtin_amdgcn_readfirstlane(tid >> 6);
    const size_t rowbase = (size_t)b * SEQ;
    const int qw = q0 + wid * 32 * NB;
    const int cwv = qw >> 6, c0 = q0 >> 6;
    const int tlo = BIAS ? (c0 - 8 > 0 ? c0 - 8 : 0) : 0, thi = c0 + 4 * NB;
    const int wlo = BIAS ? (cwv - 8 > 0 ? cwv - 8 : 0) : 0, whi = cwv;
    LAS float* wsf = (LAS float*)(lds + OFF_WSF) + wid * 64 * NB;
    LAS float* bt = (LAS float*)(lds + OFF_BT);
    bf16x8 qf[NB][ND];
#pragma unroll
    for (int nb = 0; nb < NB; ++nb) {
        const size_t qrow = rowbase + qw + nb * 32 + r32;
#pragma unroll
        for (int d0 = 0; d0 < 4; ++d0) qf[nb][d0] = *(const bf16x8*)(Qn + qrow * DM + h * 64 + d0 * 16 + hi * 8);
        if constexpr (DQK == 96) {
#pragma unroll
            for (int d0 = 4; d0 < 6; ++d0) qf[nb][d0] = *(const bf16x8*)(Qr + qrow * DM + h * 32 + (d0 - 4) * 16 + hi * 8);
        }
    }
    if constexpr (BIAS) { for (int i = tid; i < 257; i += 512) bt[i] = biasg[i] * LOG2E; }
    const int ka_key = tid / NC, ka_c = tid % NC, kb_key = (tid + 512) / NC, kb_c = (tid + 512) % NC, v_key = tid >> 3, v_c = tid & 7;
    const bool has_kb = (DQK == 96) && (tid < 256);
    const int ka_dst = ka_c * 1024 + ka_key * 16, kb_dst = kb_c * 1024 + kb_key * 16;
    const int v_dst = (v_c >> 2) * 4096 + (v_key >> 4) * 1024 + (v_key & 15) * 64 + (v_c & 3) * 16;
    const bf16_t* pa_src = (ka_c < 8) ? Kn + (rowbase + ka_key) * DM + h * 64 + ka_c * 8 : Kr + (rowbase + ka_key) * ROPE + (ka_c - 8) * 8;
    const bf16_t* pb_src = (kb_c < 8) ? Kn + (rowbase + kb_key) * DM + h * 64 + kb_c * 8 : Kr + (rowbase + kb_key) * ROPE + (kb_c - 8) * 8;
    const int pa_step = (ka_c < 8) ? 64 * DM : 64 * ROPE, pb_step = (kb_c < 8) ? 64 * DM : 64 * ROPE;
    const bf16_t* pv_src = Vg + (rowbase + v_key) * DM + h * 64 + v_c * 8;
    u32x4 ra, rb, rv;
#define ATT_LOAD(t) do { ra = *(const u32x4*)(pa_src + (size_t)(t) * pa_step); if (has_kb) rb = *(const u32x4*)(pb_src + (size_t)(t) * pb_step); rv = *(const u32x4*)(pv_src + (size_t)(t) * 64 * DM); } while (0)
#define ATT_STORE(buf) do { *(LAS u32x4*)(lds + (buf) * KSZ + ka_dst) = ra; if (has_kb) *(LAS u32x4*)(lds + (buf) * KSZ + kb_dst) = rb; \
        *(LAS u32x4*)(lds + OFF_V + (buf) * 8192 + v_dst) = rv; } while (0)
    rb = (u32x4){0u, 0u, 0u, 0u};
    ATT_LOAD(tlo); ATT_STORE(0);
    __syncthreads();
    float mrun[NB], lrun[NB]; f32x16 o0[NB], o1[NB];
#pragma unroll
    for (int nb = 0; nb < NB; ++nb) { mrun[nb] = 0.f; lrun[nb] = 0.f; o0[nb] = (f32x16){}; o1[nb] = (f32x16){}; }
    const int vrd = (4 * hi + ((lane & 15) >> 2)) * 64 + ((lane >> 4) & 1) * 32 + (lane & 3) * 8;
    for (int t = tlo; t < thi; ++t) {
        const int cur = (t - tlo) & 1;
        const bool more = (t + 1 < thi);
        if (more) ATT_LOAD(t + 1);
        if (t >= wlo && t <= whi) {
            const LAS unsigned char* Kb = lds + cur * KSZ + hi * 1024 + r32 * 16;
            const LAS unsigned char* Vb = lds + OFF_V + cur * 8192 + vrd;
            f32x16 p0[NB], p1[NB];
#pragma unroll
            for (int nb = 0; nb < NB; ++nb) { p0[nb] = (f32x16){}; p1[nb] = (f32x16){}; }
            {
                bf16x8 k0 = *(const LAS bf16x8*)(Kb), k1 = *(const LAS bf16x8*)(Kb + 512);
#pragma unroll
                for (int d0 = 0; d0 < ND; ++d0) {
                    bf16x8 n0 = k0, n1 = k1;
                    if (d0 + 1 < ND) { n0 = *(const LAS bf16x8*)(Kb + (d0 + 1) * 2048); n1 = *(const LAS bf16x8*)(Kb + (d0 + 1) * 2048 + 512); }
                    __builtin_amdgcn_sched_barrier(0);
#pragma unroll
                    for (int nb = 0; nb < NB; ++nb) { p0[nb] = MFMA32(k0, qf[nb][d0], p0[nb]); p1[nb] = MFMA32(k1, qf[nb][d0], p1[nb]); }
                    __builtin_amdgcn_sched_barrier(0);
                    k0 = n0; k1 = n1;
                }
            }
            u32x4 pw[NB][4];
#pragma unroll
            for (int nb = 0; nb < NB; ++nb) {
                if constexpr (BIAS) {
                    const int dbase = qw + nb * 32 - t * 64;
                    if (dbase - 63 >= 128) { const float cb = bt[256];
#pragma unroll
                        for (int i = 0; i < 16; ++i) { p0[nb][i] += cb; p1[nb][i] += cb; } }
                    else {
#pragma unroll
                        for (int i = 0; i < 16; ++i) { const int d = dbase + r32 - crow(i, hi); const int i0 = (d < 128 ? d : 128) + 128, i1 = (d - 32 < 128 ? d - 32 : 128) + 128;
                            p0[nb][i] += bt[i0]; p1[nb][i] += bt[i1]; }
                    }
                }
                float ra_ = fmaxf(fmaxf(p0[nb][0], p1[nb][0]), p0[nb][1]), rb_ = fmaxf(fmaxf(p1[nb][1], p0[nb][2]), p1[nb][2]);
#pragma unroll
                for (int i = 3; i < 15; i += 2) { ra_ = fmaxf(fmaxf(ra_, p0[nb][i]), p1[nb][i]); rb_ = fmaxf(fmaxf(rb_, p0[nb][i + 1]), p1[nb][i + 1]); }
                float rm = fmaxf(fmaxf(ra_, rb_), fmaxf(p0[nb][15], p1[nb][15]));
                rm = fmaxf(rm, lane_read(rm, lane ^ 32));
                if (t == wlo) { mrun[nb] = rm; }
                else if (__any(rm > mrun[nb] + 8.0f)) {
                    const float dl = fmaxf(rm - mrun[nb], 0.f); const float al = __builtin_amdgcn_exp2f(-dl); mrun[nb] += dl; lrun[nb] *= al;
                    if (hi == 0) wsf[nb * 64 + r32] = al;
#pragma unroll
                    for (int i = 0; i < 16; ++i) { const float a = wsf[nb * 64 + crow(i, hi)]; o0[nb][i] *= a; o1[nb][i] *= a; }
                }
                float ls0 = 0.f, ls1 = 0.f; const float mm = mrun[nb];
#pragma unroll
                for (int i = 0; i < 16; ++i) { p0[nb][i] = __builtin_amdgcn_exp2f(p0[nb][i] - mm); p1[nb][i] = __builtin_amdgcn_exp2f(p1[nb][i] - mm); ls0 += p0[nb][i]; ls1 += p1[nb][i]; }
                lrun[nb] += ls0 + ls1;
#pragma unroll
                for (int k = 0; k < 4; ++k) { pw[nb][0][k] = cvt_pk_bf16(p0[nb][2 * k], p0[nb][2 * k + 1]); pw[nb][1][k] = cvt_pk_bf16(p0[nb][8 + 2 * k], p0[nb][8 + 2 * k + 1]);
                    pw[nb][2][k] = cvt_pk_bf16(p1[nb][2 * k], p1[nb][2 * k + 1]); pw[nb][3][k] = cvt_pk_bf16(p1[nb][8 + 2 * k], p1[nb][8 + 2 * k + 1]); }
            }
            {
                s16x4 a0 = vtr(Vb), a1 = vtr(Vb + 512), c0_ = vtr(Vb + 4096), c1_ = vtr(Vb + 4096 + 512);
#pragma unroll
                for (int ks = 0; ks < 4; ++ks) {
                    const bf16x8 v0 = (bf16x8){a0[0], a0[1], a0[2], a0[3], a1[0], a1[1], a1[2], a1[3]}, v1 = (bf16x8){c0_[0], c0_[1], c0_[2], c0_[3], c1_[0], c1_[1], c1_[2], c1_[3]};
                    if (ks + 1 < 4) { a0 = vtr(Vb + (ks + 1) * 1024); a1 = vtr(Vb + (ks + 1) * 1024 + 512); c0_ = vtr(Vb + 4096 + (ks + 1) * 1024); c1_ = vtr(Vb + 4096 + (ks + 1) * 1024 + 512); }
                    __builtin_amdgcn_sched_barrier(0);
#pragma unroll
                    for (int nb = 0; nb < NB; ++nb) { const bf16x8 pa = __builtin_bit_cast(bf16x8, pw[nb][ks]); o0[nb] = MFMA32(pa, v0, o0[nb]); o1[nb] = MFMA32(pa, v1, o1[nb]); }
                    __builtin_amdgcn_sched_barrier(0);
                }
            }
        }
        if (more) ATT_STORE(cur ^ 1);
        __syncthreads();
    }
#undef ATT_LOAD
#undef ATT_STORE
#pragma unroll
    for (int nb = 0; nb < NB; ++nb) {
        float lt = lrun[nb]; lt += lane_read(lt, lane ^ 32);
        if (hi == 0) wsf[nb * 64 + 32 + r32] = lt;
        bf16_t* Ow = Og + (rowbase + qw + nb * 32) * DM + h * 64 + r32;
#pragma unroll
        for (int i = 0; i < 16; ++i) { const int q = crow(i, hi); const float rl = __builtin_amdgcn_rcpf(wsf[nb * 64 + 32 + q]);
            const unsigned w0 = cvt_pk_bf16(o0[nb][i] * rl, 0.f), w1 = cvt_pk_bf16(o1[nb][i] * rl, 0.f);
            Ow[(size_t)q * DM] = (bf16_t)(w0 & 0xffffu); Ow[(size_t)q * DM + 32] = (bf16_t)(w1 & 0xffffu); }
    }
    __syncthreads();
}
#undef MFMA32
}
__device__ const float INV_FREQ[16] = {1.000000000e+00f, 5.623413324e-01f, 3.162277639e-01f, 1.778279394e-01f, 1.000000015e-01f, 5.623413250e-02f, 3.162277490e-02f, 1.778279431e-02f,
                                       9.999999776e-03f, 5.623413250e-03f, 3.162277630e-03f, 1.778279431e-03f, 1.000000047e-03f, 5.623413017e-04f, 3.162277571e-04f, 1.778279402e-04f};
__device__ __forceinline__ unsigned f2bf(float f) { unsigned u = __builtin_bit_cast(unsigned, f); return (u + 0x7fffu + ((u >> 16) & 1u)) >> 16; }
__device__ __forceinline__ unsigned pk2(float lo, float hi) { return f2bf(lo) | (f2bf(hi) << 16); }

struct Params { const void* in[28]; float* out; unsigned char* ws; };
__device__ __forceinline__ const void* karg(int i) { int z = 0; asm volatile("" : "+s"(z)); const void* const* kp = (const void* const*)__builtin_amdgcn_kernarg_segment_ptr(); return kp[i + z]; }
#define KIN(i) ((const float*)karg(i))
#define KOUT ((float*)karg(28))
#define KWS(off) ((unsigned char*)karg(29) + (off))

__device__ __forceinline__ void transpose_item(const float* W, int K, int N, bf16_t* WT, int mode, int row_off, const float* kscale, LAS float* scr, int item, int lane) {
    const int nblk = N / 32, kb = item / nblk, nb = item % nblk, k0 = 64 * kb, n0 = 32 * nb;
#pragma unroll 8
    for (int i = 0; i < 32; ++i) { const int kk = 2 * i + (lane >> 5); float v = W[(size_t)(k0 + kk) * N + n0 + (lane & 31)]; if (kscale) v *= kscale[k0 + kk]; scr[kk * 33 + (lane & 31)] = v; }
    asm volatile("s_waitcnt lgkmcnt(0)" ::: "memory");
    const int c = lane & 7;
#pragma unroll
    for (int j = 0; j < 4; ++j) { const int n = (lane >> 3) + 8 * j; const LAS float* s = scr + (8 * c) * 33 + n;
        u32x4 o; o.x = pk2(s[0 * 33], s[1 * 33]); o.y = pk2(s[2 * 33], s[3 * 33]); o.z = pk2(s[4 * 33], s[5 * 33]); o.w = pk2(s[6 * 33], s[7 * 33]);
        const int nn = n0 + n; int drow;
        if (mode == 0) drow = row_off + nn; else { const int jj = nn < FFN ? nn : nn - FFN; drow = 256 * (jj >> 7) + (nn < FFN ? 0 : 128) + (jj & 127); }
        *(u32x4*)(WT + (size_t)drow * K + k0 + 8 * c) = o; }
    asm volatile("s_waitcnt lgkmcnt(0)" ::: "memory");
}

__device__ __forceinline__ void p0_prologue(LAS unsigned char* lds, int G, int bx) {
    int tid_ = threadIdx.x; asm volatile("" : "+v"(tid_));
    const int tid = tid_, lane = tid & 63; const int wid = __builtin_amdgcn_readfirstlane(tid >> 6);
    unsigned char* ws = KWS(0);
    float* modv = (float*)(ws + WS_MODV);
    {
        LAS float* ca = (LAS float*)lds; LAS float* red = ca + 2048;
        const float* c = KIN(1);
        for (int i = tid; i < 2048; i += 512) { const float v = c[i]; ca[i] = v / (1.0f + __expf(-v)); }
        __syncthreads();
        for (int item = bx; item < 224; item += G) {
            const int col = item * 64; const float* W; const float* bias; float* out; int N, ostride;
            if (col < 12288) { const int l = col / 6144, cc = col % 6144; W = KIN(3) + (size_t)l * 1024 * 6144 + cc; N = 6144; bias = KIN(4) + l * 6144 + cc; out = modv + (size_t)l * 2 * 6144 + cc; ostride = 6144; }
            else { const int cc = col - 12288; W = KIN(10) + cc; N = 2048; bias = KIN(11) + cc; out = modv + 24576 + cc; ostride = 2048; }
            float a0 = 0.f, a1 = 0.f; const int kb = wid * 128;
#pragma unroll 16
            for (int k = 0; k < 128; ++k) { const float w = W[(size_t)(kb + k) * N + lane]; a0 += ca[kb + k] * w; a1 += ca[1024 + kb + k] * w; }
            red[(wid * 2 + 0) * 64 + lane] = a0; red[(wid * 2 + 1) * 64 + lane] = a1;
            __syncthreads();
            if (tid < 128) { const int bb = tid >> 6, ln = tid & 63; float s = 0.f;
#pragma unroll
                for (int w = 0; w < 8; ++w) s += red[(w * 2 + bb) * 64 + ln];
                out[(size_t)bb * ostride + ln] = s + bias[ln]; }
            __syncthreads();
        }
    }
    __syncthreads();
    {
        LAS float* scr = (LAS float*)(lds + wid * 16384);
        const int gw = bx * 8 + wid, NGW = G * 8;
        bf16_t* WQKV = (bf16_t*)(ws + WS_WQKV); bf16_t* WO = (bf16_t*)(ws + WS_WO); bf16_t* WIN = (bf16_t*)(ws + WS_WIN); bf16_t* WOUT = (bf16_t*)(ws + WS_WOUT);
        bf16_t* WLD = (bf16_t*)(ws + WS_WLD); bf16_t* WKVUP = (bf16_t*)(ws + WS_WKVUP); bf16_t* WQUP = (bf16_t*)(ws + WS_WQUP); bf16_t* BWO = (bf16_t*)(ws + WS_BWO);
        constexpr int NITEMS = 1536 + 512 + 2 * 2816 + 2 * 1408 + 128 + 16 + 192 + 128 + 128 + 192 + 96 + 512;
        for (int it = gw; it < NITEMS; it += NGW) {
            int r = it;
            if (r < 1536) { transpose_item(KIN(7), 1024, 3072, WQKV, 0, 0, nullptr, scr, r, lane); continue; } r -= 1536;
            if (r < 512) { transpose_item(KIN(8), 1024, 1024, WO, 0, 0, nullptr, scr, r, lane); continue; } r -= 512;
            if (r < 5632) { const int l = r / 2816; transpose_item(KIN(23) + (size_t)l * 1024 * FFN2, 1024, FFN2, WIN + (size_t)l * FFN2 * 1024, 1, 0, nullptr, scr, r % 2816, lane); continue; } r -= 5632;
            if (r < 2816) { const int l = r / 1408; transpose_item(KIN(26) + (size_t)l * FFN * 1024, FFN, 1024, WOUT + (size_t)l * 1024 * FFN, 0, 0, nullptr, scr, r % 1408, lane); continue; } r -= 2816;
            if (r < 128) { transpose_item(KIN(13), 1024, 256, WLD, 0, 0, nullptr, scr, r, lane); continue; } r -= 128;
            if (r < 16) { transpose_item(KIN(17), 1024, 32, WLD, 0, 256, nullptr, scr, r, lane); continue; } r -= 16;
            if (r < 192) { transpose_item(KIN(18), 1024, 384, WLD, 0, 512, nullptr, scr, r, lane); continue; } r -= 192;
            if (r < 128) { transpose_item(KIN(15), 256, 1024, WKVUP, 0, 0, KIN(14), scr, r, lane); continue; } r -= 128;
            if (r < 128) { transpose_item(KIN(16), 256, 1024, WKVUP, 0, 1024, KIN(14), scr, r, lane); continue; } r -= 128;
            if (r < 192) { transpose_item(KIN(20), 384, 1024, WQUP, 0, 0, KIN(19), scr, r, lane); continue; } r -= 192;
            if (r < 96) { transpose_item(KIN(21), 384, 512, WQUP, 0, 1024, KIN(19), scr, r, lane); continue; } r -= 96;
            transpose_item(KIN(22), 1024, 1024, BWO, 0, 0, nullptr, scr, r, lane);
        }
        const int gt = bx * 512 + tid, NGT = G * 512;
        for (int i = gt; i < 352 * 128; i += NGT) { const int rr = i >> 7, piece = i & 127; const int row = rr < 224 ? 288 + rr : 896 + (rr - 224);
            *(u32x4*)(WLD + (size_t)row * 1024 + piece * 8) = (u32x4){0u, 0u, 0u, 0u}; }
        const int* pos = (const int*)karg(2); float* cosT = (float*)(ws + WS_COS); float* sinT = (float*)(ws + WS_SIN);
        for (int i = gt; i < T * 16; i += NGT) { const int t = i >> 4, j = i & 15; const float ang = (float)pos[t] * INV_FREQ[j];
            const double rev = (double)ang * 0.15915494309189535; const float fr = (float)(rev - rint(rev));
            cosT[i] = __builtin_amdgcn_cosf(fr); sinT[i] = __builtin_amdgcn_sinf(fr); }
    }
}

__device__ __forceinline__ float row_rstd(const float* xrow, int lane, f32x4 (&v)[4]) {
    float s = 0.f;
#pragma unroll
    for (int j = 0; j < 4; ++j) { v[j] = ((const f32x4*)xrow)[64 * j + lane]; s += (v[j].x * v[j].x + v[j].y * v[j].y) + (v[j].z * v[j].z + v[j].w * v[j].w); }
    return __builtin_amdgcn_rsqf(wave_sum(s, lane) * (1.0f / DM) + EPS);
}
__device__ __forceinline__ void mod_store(const f32x4 (&v)[4], float rstd, const float* g, const float* sh, const float* sc, bf16_t* orow, int lane) {
#pragma unroll
    for (int j = 0; j < 4; ++j) { const f32x4 gg = ((const f32x4*)g)[64 * j + lane], ss = ((const f32x4*)sh)[64 * j + lane], cc = ((const f32x4*)sc)[64 * j + lane];
        const f32x4 y = (v[j] * rstd * gg) * (cc + 1.0f) + ss;
        u32x2 w; w.x = cvt_pk_bf16(y.x, y.y); w.y = cvt_pk_bf16(y.z, y.w); ((u32x2*)orow)[64 * j + lane] = w; }
}
#define XB_TMO      128
#define XB_XCNT(j)  (256  + 64 * (j))
#define XB_XSUB(j)  (1280 + 64 * (j))
#define XB_XGEN(j)  (2304 + 64 * (j))
#define XB_TOP      3328
#define XB_TOPGEN   3392
#define XCD_BAR_WORDS 3456
#define XB_SPIN_CAP (1u << 18)

__device__ __forceinline__ unsigned xb_ld(unsigned* p)              { return __hip_atomic_load(p, __ATOMIC_RELAXED, __HIP_MEMORY_SCOPE_AGENT); }
__device__ __forceinline__ unsigned xb_add(unsigned* p, unsigned v) { return __hip_atomic_fetch_add(p, v, __ATOMIC_RELAXED, __HIP_MEMORY_SCOPE_AGENT); }
__device__ __forceinline__ unsigned xb_xcc_id() { return (unsigned)__builtin_amdgcn_s_getreg((3 << 11) | 20) & 0xFu; }
#define XB_SPIN(cond, bar) do { unsigned _sp = 0; while (cond) { __builtin_amdgcn_s_sleep(1); \
    if ((++_sp & 255u) == 0u) { if (xb_ld(&(bar)[XB_TMO])) break; if (_sp > XB_SPIN_CAP) { atomicAdd(&(bar)[XB_TMO], 1u); break; } } } } while (0)

struct XcdBarrier {
    unsigned* bar; unsigned x;
    volatile LAS unsigned* st;
};

__device__ __forceinline__ XcdBarrier xcd_barrier_post(unsigned* bar, volatile LAS unsigned* st) {
    XcdBarrier b; b.bar = bar; b.x = xb_xcc_id(); b.st = st;
    if (threadIdx.x == 0) (void)xb_add(&bar[XB_XCNT(b.x)], 1u);
    return b;
}
__device__ __forceinline__ void xcd_barrier_complete(unsigned* bar, unsigned x, unsigned& nloc, unsigned& nx) {
    const unsigned G = gridDim.x * gridDim.y * gridDim.z;
    unsigned sum, cnt, mine, sp = 0u;
    for (;;) {
        sum = 0u; cnt = 0u; mine = 0u;
#pragma unroll
        for (unsigned j = 0; j < 16; ++j) { const unsigned c = xb_ld(&bar[XB_XCNT(j)]); sum += c; cnt += (c > 0u) ? 1u : 0u; mine = (j == x) ? c : mine; }
        if (sum == G) break;
        __builtin_amdgcn_s_sleep(1);
        if ((++sp & 255u) == 0u) { if (xb_ld(&bar[XB_TMO])) break; if (sp > XB_SPIN_CAP) { atomicAdd(&bar[XB_TMO], 1u); break; } }
    }
    nloc = mine > 0u ? mine : 1u; nx = cnt > 0u ? cnt : 1u;
}

__device__ __forceinline__ void xcd_barrier(const XcdBarrier& b) {
    asm volatile("s_waitcnt vmcnt(0)" ::: "memory");
    __syncthreads();
    if (threadIdx.x == 0) {
        unsigned* bar = b.bar;
        __builtin_amdgcn_s_waitcnt(0);
        unsigned nloc = b.st[0], nx = b.st[1];
        if (nloc == 0u) { xcd_barrier_complete(bar, b.x, nloc, nx); b.st[0] = nloc; b.st[1] = nx; }
        const unsigned old = xb_add(&bar[XB_XSUB(b.x)], 1u);
        const unsigned gen = old / nloc;
        if (old + 1u == (gen + 1u) * nloc) {
            __builtin_amdgcn_fence(__ATOMIC_RELEASE, "agent");
            asm volatile("s_waitcnt vmcnt(0)" ::: "memory");
            const unsigned og = xb_add(&bar[XB_TOP], 1u);
            const unsigned tg = og / nx;
            if (og + 1u == (tg + 1u) * nx) xb_add(&bar[XB_TOPGEN], 1u);
            else XB_SPIN(xb_ld(&bar[XB_TOPGEN]) == tg, bar);
            __builtin_amdgcn_fence(__ATOMIC_ACQUIRE, "agent");
            xb_add(&bar[XB_XGEN(b.x)], 1u);
            asm volatile("s_waitcnt vmcnt(0)" ::: "memory");
        } else {
            XB_SPIN(xb_ld(&bar[XB_XGEN(b.x)]) == gen, bar);
            __builtin_amdgcn_fence(__ATOMIC_ACQUIRE, "agent");
            asm volatile("s_waitcnt vmcnt(0)" ::: "memory");
        }
    }
    __syncthreads();
}

template <class Epi, class S_> __device__ __forceinline__ void run_gemm(LAS unsigned char* lds, int K, const S_& S, const Epi& E) { pg8::gemm_phase<Epi, S_, true, true>(lds, K, S, E); }

__global__ void __launch_bounds__(512) fwd_megakernel(Params P) {
    extern __shared__ __attribute__((aligned(16))) unsigned char lds_raw[];
    LAS unsigned char* lds = (LAS unsigned char*)lds_raw;
    cg::grid_group grid = cg::this_grid();
    const int wid = __builtin_amdgcn_readfirstlane((int)threadIdx.x >> 6);
#define OPAQUE_LANE() unsigned om_ = ~0u; asm volatile("" : "+s"(om_)); int lane = __builtin_amdgcn_mbcnt_hi(om_, __builtin_amdgcn_mbcnt_lo(om_, 0u)); asm volatile("" : "+v"(lane))
#define OPAQUE_GRID() int G = G0, bx = bx0, gw = gw0, NGW = NGW0; asm volatile("" : "+s"(G), "+s"(bx), "+s"(gw), "+s"(NGW))
    const int G0 = gridDim.x, bx0 = blockIdx.x;
    const int gw0 = bx0 * 8 + wid, NGW0 = G0 * 8;
#define MODV ((float*)KWS(WS_MODV))
#define BF(off) ((bf16_t*)KWS(off))

    { unsigned* bw = (unsigned*)KWS(WS_BAR); if (bx0 == 0) for (int i = threadIdx.x; i < XCD_BAR_WORDS; i += 512) bw[i] = 0u;
      if (threadIdx.x < 2) ((volatile LAS unsigned*)(lds + MISC_OFF))[threadIdx.x] = 0u; }
    for (int rep = 0; rep < REP_P0; ++rep) { if (PH & 1) { OPAQUE_GRID(); (void)gw; (void)NGW; p0_prologue(lds, G, bx); } __syncthreads(); }
    grid.sync();
    const XcdBarrier xbar = xcd_barrier_post((unsigned*)KWS(WS_BAR), (volatile LAS unsigned*)(lds + MISC_OFF));
#define GRID_SYNC() xcd_barrier(xbar)
    for (int rep = 0; rep < EXTRA_SYNCS; ++rep) GRID_SYNC();

#pragma unroll 1
    for (int l = 0; l < 2; ++l) {
        if (l == 0) {
            { OPAQUE_LANE(); OPAQUE_GRID(); (void)G; (void)bx; const float* x = KIN(0); const float* modl = MODV; bf16_t* HN = BF(WS_HN); const float* g = KIN(5);
              for (int rep = 0; rep < REP_NORM1; ++rep)
              for (int m = gw; m < T; m += NGW) { const int b = m / SEQ; f32x4 v[4]; const float rstd = row_rstd(x + (size_t)m * DM, lane, v);
                mod_store(v, rstd, g, modl + b * 6144, modl + b * 6144 + 1024, HN + (size_t)m * DM, lane); } }
            GRID_SYNC();
            if (PH & 2) { OPAQUE_GRID(); (void)gw; (void)NGW; pg8::Sched<0> S; S.init(64, 12, 1024, KWS(WS_HN), nullptr, KWS(WS_WQKV), G, bx);
              pg8::EpiBf16 E{BF(WS_R1), DM, DM, (size_t)16 * 1024 * 1024, QS_A};
              for (int rep = 0; rep < REP_QKV; ++rep) run_gemm(lds, 1024, S, E); }
            GRID_SYNC();
            if (PH & 4) { OPAQUE_GRID(); (void)gw; (void)NGW; const bf16_t* R1 = BF(WS_R1); const bf16_t* R2 = BF(WS_R2); const bf16_t* R3 = BF(WS_R3); const float* rb = KIN(9);
              for (int rep = 0; rep < REP_ATTA; ++rep)
              for (int u = bx; u < 1024; u += G) { const int qb = u & 31, bh = u >> 5;
                att::attn_unit<64, true, 1>(lds, bh >> 4, bh & 15, qb * 256, R1, nullptr, R2, nullptr, R3, BF(WS_HN), rb + (bh & 15) * 257); } }
        } else {
            { OPAQUE_LANE(); OPAQUE_GRID(); (void)G; (void)bx; const float* out = KOUT; const float* modl = MODV + 2 * 6144; const float* kvmod = MODV + 24576; bf16_t* HN = BF(WS_HN); bf16_t* HN1 = BF(WS_HN1);
              const float* gkv = KIN(12); const float* g1 = KIN(5) + DM;
              for (int m = gw; m < T; m += NGW) { const int b = m / SEQ; f32x4 v[4]; const float rstd = row_rstd(out + (size_t)m * DM, lane, v);
                mod_store(v, rstd, gkv, kvmod + b * 2048, kvmod + b * 2048 + 1024, HN + (size_t)m * DM, lane);
                mod_store(v, rstd, g1, modl + b * 6144, modl + b * 6144 + 1024, HN1 + (size_t)m * DM, lane); } }
            GRID_SYNC();
            if (PH & 8) { OPAQUE_GRID(); (void)gw; (void)NGW; pg8::Sched<2> S; S.init(64, 4, 1024, KWS(WS_HN), KWS(WS_HN1), KWS(WS_WLD), G, bx);
              pg8::EpiLatDown E{BF(WS_CKV), BF(WS_CQ), BF(WS_KR), (float*)KWS(WS_SSQKV), (float*)KWS(WS_SSQQ), (const float*)KWS(WS_COS), (const float*)KWS(WS_SIN)}; run_gemm(lds, 1024, S, E); }
            GRID_SYNC();
            if (PH & 16) { OPAQUE_GRID(); (void)gw; (void)NGW; pg8::Sched<0> S; S.init(64, 8, KVL, KWS(WS_CKV), nullptr, KWS(WS_WKVUP), G, bx);
              pg8::EpiLatUp<false> E{BF(WS_R2), BF(WS_R3), (const float*)KWS(WS_SSQKV), (const float*)KWS(WS_COS), (const float*)KWS(WS_SIN)}; run_gemm(lds, KVL, S, E); }
            if (PH & 32) { OPAQUE_GRID(); (void)gw; (void)NGW; pg8::Sched<0> S; S.init(64, 6, QL, KWS(WS_CQ), nullptr, KWS(WS_WQUP), G, bx);
              pg8::EpiLatUp<true> E{BF(WS_R1), BF(WS_R4), (const float*)KWS(WS_SSQQ), (const float*)KWS(WS_COS), (const float*)KWS(WS_SIN)}; run_gemm(lds, QL, S, E); }
            GRID_SYNC();
            if (PH & 64) { OPAQUE_GRID(); (void)gw; (void)NGW; const bf16_t* R1 = BF(WS_R1); const bf16_t* R2 = BF(WS_R2); const bf16_t* R3 = BF(WS_R3); const bf16_t* R4 = BF(WS_R4); const bf16_t* KR = BF(WS_KR);
              for (int rep = 0; rep < REP_MLA; ++rep)
              for (int v0 = bx; v0 < 256; v0 += G) { const int vcu = (G == 256) ? (v0 % 8) * 32 + v0 / 8 : v0; const int bh = vcu >> 3, s = vcu & 7;
#pragma unroll 1
                for (int i = 0; i < 2; ++i) { const int qb = (i == 0) ? s : 15 - s;
                    att::attn_unit<96, false, 2>(lds, bh >> 4, bh & 15, qb * 512, R1, R4, R2, KR, R3, BF(WS_HN), nullptr); } } }
        }
        GRID_SYNC();
        if (PH & 128) { OPAQUE_GRID(); (void)gw; (void)NGW; pg8::Sched<0> S; S.init(64, 4, 1024, KWS(WS_HN), nullptr, KWS(l == 0 ? WS_WO : WS_BWO), G, bx);
          pg8::EpiRes E{l == 0 ? KIN(0) : (const float*)KOUT, KOUT, MODV + (size_t)l * 2 * 6144 + 2048}; run_gemm(lds, 1024, S, E); }
        GRID_SYNC();
        { OPAQUE_LANE(); OPAQUE_GRID(); (void)G; (void)bx; const float* out = KOUT; const float* modl = MODV + (size_t)l * 2 * 6144; bf16_t* HN = BF(WS_HN); const float* g = KIN(6) + l * DM;
          for (int m = gw; m < T; m += NGW) { const int b = m / SEQ, s = m % SEQ; f32x4 v[4]; const float rstd = row_rstd(out + (size_t)m * DM, lane, v);
            mod_store(v, rstd, g, modl + b * 6144 + 3072, modl + b * 6144 + 4096, HN + ((size_t)b * PADROWS + 2 + s) * DM, lane); }
          if (gw < 4) { bf16_t* z = HN + ((size_t)(gw >> 1) * PADROWS + (gw & 1)) * DM;
#pragma unroll
            for (int j = 0; j < 4; ++j) ((u32x2*)z)[64 * j + lane] = (u32x2){0u, 0u}; } }
        GRID_SYNC();
        if (PH & 256) { OPAQUE_GRID(); (void)gw; (void)NGW; pg8::Sched<1> S; S.init(2 * FT, 22, 1024, KWS(WS_HN), nullptr, KWS(WS_WIN + (size_t)l * FFN2 * 1024 * 2), G, bx);
          pg8::EpiConv E{KIN(24) + (size_t)l * 3 * FFN2, KIN(25) + (size_t)l * FFN2, BF(WS_ACT)};
          for (int rep = 0; rep < REP_FFNIN; ++rep) run_gemm(lds, 1024, S, E); }
        GRID_SYNC();
        if (PH & 512) { OPAQUE_GRID(); (void)gw; (void)NGW; pg8::Sched<0> S; S.init(64, 4, FFN, KWS(WS_ACT), nullptr, KWS(WS_WOUT + (size_t)l * 1024 * FFN * 2), G, bx);
          pg8::EpiRes E{KOUT, KOUT, MODV + (size_t)l * 2 * 6144 + 5120}; run_gemm(lds, FFN, S, E); }
        GRID_SYNC();
    }
    { OPAQUE_LANE(); OPAQUE_GRID(); (void)G; (void)bx; float* out = KOUT; const f32x4* fg = (const f32x4*)karg(27);
      for (int m = gw; m < T; m += NGW) { f32x4 v[4]; const float rstd = row_rstd(out + (size_t)m * DM, lane, v);
#pragma unroll
        for (int j = 0; j < 4; ++j) { const f32x4 gg = fg[64 * j + lane]; ((f32x4*)(out + (size_t)m * DM))[64 * j + lane] = v[j] * rstd * gg; } } }
}

extern "C" void kernel_launch(void* const* d_in, const int* in_sizes, int n_in, void* d_out, int out_size, void* d_ws, size_t ws_size, hipStream_t stream) {
    static int grid_blocks = 0;
    if (grid_blocks == 0) {
        if (n_in != 28 || out_size != T * DM || ws_size < WS_END) { fprintf(stderr, "kernel_launch: unexpected problem (n_in %d out %d ws %zu)\n", n_in, out_size, ws_size); grid_blocks = -1; return; }
        int dev = 0, cus = 0, per_cu = 0;
        hipGetDevice(&dev); hipDeviceGetAttribute(&cus, hipDeviceAttributeMultiprocessorCount, dev);
        if (hipFuncSetAttribute((const void*)fwd_megakernel, hipFuncAttributeMaxDynamicSharedMemorySize, LDS_BYTES) != hipSuccess) { fprintf(stderr, "kernel_launch: hipFuncSetAttribute failed\n"); grid_blocks = -1; return; }
        if (hipOccupancyMaxActiveBlocksPerMultiprocessor(&per_cu, (const void*)fwd_megakernel, 512, LDS_BYTES) != hipSuccess || per_cu < 1) { fprintf(stderr, "kernel_launch: occupancy query says %d\n", per_cu); per_cu = 1; (void)hipGetLastError(); }
        grid_blocks = cus * per_cu;
        if (grid_blocks > 256) grid_blocks = 256;
    }
    if (grid_blocks < 0) return;
    Params p{};
    for (int i = 0; i < 28; ++i) p.in[i] = d_in[i];
    p.out = (float*)d_out; p.ws = (unsigned char*)d_ws;
    void* args[] = {&p};
    hipError_t e = hipLaunchCooperativeKernel((const void*)fwd_megakernel, dim3(grid_blocks), dim3(512), args, LDS_BYTES, stream);
    if (e != hipSuccess) fprintf(stderr, "cooperative launch failed: %s (grid %d)\n", hipGetErrorString(e), grid_blocks);
}
```

```cpp
#include <hip/hip_runtime.h>
#include <hip/hip_cooperative_groups.h>
#include <cstdio>
#include <cstdint>
#ifndef REP_MLA
#define REP_MLA 1
#endif
#ifndef REP_ATTA
#define REP_ATTA 1
#endif
#ifndef REP_FFNIN
#define REP_FFNIN 1
#endif
#ifndef REP_QKV
#define REP_QKV 1
#endif
#ifndef REP_P0
#define REP_P0 1
#endif
#ifndef EXTRA_SYNCS
#define EXTRA_SYNCS 0
#endif
#ifndef REP_NORM1
#define REP_NORM1 1
#endif
#ifndef REP_FFNOUT_L0
#define REP_FFNOUT_L0 0
#endif
#ifndef PH
#define PH 0xFFFF
#endif
namespace cg = cooperative_groups;

#define LAS __attribute__((address_space(3)))
typedef unsigned short bf16_t;
typedef short bf16x8 __attribute__((ext_vector_type(8)));
typedef short s16x4 __attribute__((ext_vector_type(4)));
typedef float f32x2 __attribute__((ext_vector_type(2)));
typedef float f32x4 __attribute__((ext_vector_type(4)));
typedef float f32x16 __attribute__((ext_vector_type(16)));
typedef unsigned u32x2 __attribute__((ext_vector_type(2)));
typedef unsigned u32x4 __attribute__((ext_vector_type(4)));

constexpr int BATCH = 2, SEQ = 8192, DM = 1024, T = BATCH * SEQ, FFN = 2816, FFN2 = 5632;
constexpr int NH = 16, KVL = 256, QL = 384, ROPE = 32;
constexpr int PADROWS = 8448, FT = 33;
constexpr float EPS = 1e-6f;
constexpr float LOG2E = 1.4426950408889634f;
constexpr float QS_A = 0.125f * LOG2E;
constexpr float QS_B = 0.10206207261596577f * LOG2E;

constexpr size_t MiB = 1u << 20;
constexpr size_t WS_MODV = 0;
constexpr size_t WS_SSQKV = 256 * 1024;
constexpr size_t WS_SSQQ = 512 * 1024;
constexpr size_t WS_COS = 1 * MiB, WS_SIN = 2 * MiB;
constexpr size_t WS_BAR = 3 * MiB;
constexpr size_t WS_WQKV = 4 * MiB;
constexpr size_t WS_WO = 10 * MiB;
constexpr size_t WS_WIN = 12 * MiB;
constexpr size_t WS_WOUT = 34 * MiB;
constexpr size_t WS_WLD = 45 * MiB;
constexpr size_t WS_WKVUP = 47 * MiB;
constexpr size_t WS_WQUP = 48 * MiB;
constexpr size_t WS_BWO = 50 * MiB;
constexpr size_t WS_HN = 52 * MiB;
constexpr size_t WS_R1 = 86 * MiB;
constexpr size_t WS_R2 = 118 * MiB;
constexpr size_t WS_R3 = 150 * MiB;
constexpr size_t WS_R4 = 182 * MiB;
constexpr size_t WS_ACT = 86 * MiB;
constexpr size_t WS_HN1 = 198 * MiB;
constexpr size_t WS_CKV = 230 * MiB;
constexpr size_t WS_CQ = 238 * MiB;
constexpr size_t WS_KR = 250 * MiB;
constexpr size_t WS_END = 251 * MiB;

constexpr int RING_BYTES = 131072;
constexpr int XCH_OFF = RING_BYTES;
constexpr int MISC_OFF = XCH_OFF + 8192;
constexpr int LDS_BYTES = 147456;

__device__ __forceinline__ unsigned cvt_pk_bf16(float lo, float hi) { unsigned r; asm volatile("v_cvt_pk_bf16_f32 %0, %1, %2" : "=v"(r) : "v"(lo), "v"(hi)); return r; }
__device__ __forceinline__ float lane_read(float v, int src_lane) { return __builtin_bit_cast(float, __builtin_amdgcn_ds_bpermute(src_lane << 2, __builtin_bit_cast(int, v))); }
template <int N> __device__ __forceinline__ float dpp_ror(float x) { return __builtin_bit_cast(float, __builtin_amdgcn_update_dpp(0, __builtin_bit_cast(int, x), 0x120 + N, 0xf, 0xf, false)); }
template <int N> __device__ __forceinline__ float dpp_shr_keep(float old, float x) { return __builtin_bit_cast(float, __builtin_amdgcn_update_dpp(__builtin_bit_cast(int, old), __builtin_bit_cast(int, x), 0x110 + N, 0xf, 0xf, false)); }
__device__ __forceinline__ float wave_sum(float v, int lane) {
#pragma unroll
    for (int o = 1; o < 64; o <<= 1) v += lane_read(v, lane ^ o);
    return v;
}

namespace pg8 {
#define PG8_LAS __attribute__((address_space(3)))
constexpr int BM = 256, BK = 64, HALF = 128, HTB = HALF * BK * 2, STAGE_BYTES = 8 * HTB, NXCD = 8, WGM = 8;
__host__ __device__ __forceinline__ int lds_byte(int r, int c) { const int st = (r >> 4) * 2 + (c >> 5), rr = r & 15, cc = c & 31, ob = rr * 64 + cc * 2; return st * 1024 + (ob ^ (((ob >> 9) & 1) << 5)); }
__host__ __device__ __forceinline__ void stage_rc(int b, int& R, int& C) { const int st = b / 1024, sb = b % 1024, swz = sb ^ (((sb >> 9) & 1) << 5); R = (st >> 1) * 16 + swz / 64; C = (st & 1) * 32 + (swz % 64) / 2; }
__host__ __device__ __forceinline__ int perm32(int rho) { const int n = rho >> 4, i = rho & 15; return 8 * (i >> 2) + 4 * n + (i & 3); }
struct Unit { int pm, pn; };

template <int MODE> struct Sched {
    int nM, nN, nwg, G, c, K; const char* A0; const char* A1; const char* B;
    __device__ void init(int nM_, int nN_, int K_, const void* a0, const void* a1, const void* b, int G_, int c_) { nM = nM_; nN = nN_; nwg = nM * nN; K = K_; A0 = (const char*)a0; A1 = (const char*)a1; B = (const char*)b; G = G_; c = c_; }
    __device__ bool next(int i, Unit& u) const {
        const long L = (long)i * G + c; if (L >= nwg) return false;
        int wgid = (int)L; { const int q = nwg / NXCD, r = nwg % NXCD, xcd = wgid % NXCD, off = wgid / NXCD; wgid = (xcd < r ? xcd * (q + 1) : r * (q + 1) + (xcd - r) * q) + off; }
        const int nig = WGM * nN, gid = wgid / nig, fm = gid * WGM, gsz = (nM - fm) < WGM ? (nM - fm) : WGM;
        u.pm = fm + ((wgid % nig) % gsz); u.pn = (wgid % nig) / gsz; return true;
    }
    __device__ __forceinline__ const char* abase(const Unit& u) const {
        if (MODE == 1) { const int b = u.pm / FT, i = u.pm % FT; return A0 + ((size_t)b * PADROWS + (size_t)254 * i) * (size_t)K * 2; }
        if (MODE == 2) return (u.pn < 2 ? A0 : A1) + (size_t)u.pm * 256 * K * 2;
        return A0 + (size_t)u.pm * 256 * K * 2;
    }
    __device__ __forceinline__ const char* bbase(const Unit& u) const { return B + (size_t)u.pn * 256 * K * 2; }
};
typedef const f32x4 (&AccRef)[2][2][4][2];

struct EpiBf16 {
    static constexpr bool PERM = true;
    bf16_t* O; int ldc; int split_cols; size_t split_stride; float scale0;
    __device__ __forceinline__ void operator()(AccRef acc, const Unit& u, int wr, int wc, int fr_in, int fq_in, PG8_LAS unsigned char*) const {
        int fr = fr_in, fq = fq_in; asm volatile("" : "+v"(fr), "+v"(fq));
        const int row0 = u.pm * BM + wr * 64 + fr; int colt = u.pn * BM; bf16_t* base = O;
        float sc = 1.f; if (split_cols) { const int t = colt / split_cols; base += (size_t)t * split_stride; colt -= t * split_cols; if (t == 0) sc = scale0; }
        const int col0 = colt + wc * 32 + 8 * fq;
#pragma unroll
        for (int ai = 0; ai < 2; ++ai)
#pragma unroll
            for (int m = 0; m < 4; ++m) { bf16_t* rowp = base + (size_t)(row0 + ai * HALF + m * 16) * ldc + col0;
#pragma unroll
                for (int bj = 0; bj < 2; ++bj) { f32x4 v0 = acc[ai][bj][m][0] * sc, v1 = acc[ai][bj][m][1] * sc;
                    u32x4 w; w.x = cvt_pk_bf16(v0[0], v0[1]); w.y = cvt_pk_bf16(v0[2], v0[3]); w.z = cvt_pk_bf16(v1[0], v1[1]); w.w = cvt_pk_bf16(v1[2], v1[3]);
                    *(u32x4*)(rowp + bj * HALF) = w; } }
    }
};
struct EpiRes {
    static constexpr bool PERM = false;
    const float* hin; float* hout; const float* gate;
    __device__ __forceinline__ void operator()(AccRef acc, const Unit& u, int wr, int wc, int fr_in, int fq_in, PG8_LAS unsigned char*) const {
        int fr = fr_in, fq = fq_in; asm volatile("" : "+v"(fr), "+v"(fq));
        const int row0 = u.pm * BM + wr * 64 + fr, col0 = u.pn * BM + wc * 32 + 4 * fq, b = (u.pm * BM) / SEQ;
        const float* gp = gate + (size_t)b * 6144 + col0;
        f32x4 gv[2][2];
#pragma unroll
        for (int bj = 0; bj < 2; ++bj)
#pragma unroll
            for (int n = 0; n < 2; ++n) gv[bj][n] = *(const f32x4*)(gp + bj * HALF + n * 16);
#pragma unroll
        for (int ai = 0; ai < 2; ++ai)
#pragma unroll
            for (int m = 0; m < 4; ++m) { const size_t off = (size_t)(row0 + ai * HALF + m * 16) * DM + col0;
#pragma unroll
                for (int bj = 0; bj < 2; ++bj)
#pragma unroll
                    for (int n = 0; n < 2; ++n) { const f32x4 bs = *(const f32x4*)(hin + off + bj * HALF + n * 16);
                        *(f32x4*)(hout + off + bj * HALF + n * 16) = bs + gv[bj][n] * acc[ai][bj][m][n]; }
                if (m & 1) asm volatile("" ::: "memory"); }
    }
};
struct EpiConv {
    static constexpr bool PERM = true;
    const float* cw; const float* cb; bf16_t* act;
    __device__ __forceinline__ void operator()(AccRef acc, const Unit& u, int wr, int wc, int fr_in, int fq_in, PG8_LAS unsigned char* lds) const {
        int fr = fr_in, fq = fq_in; asm volatile("" : "+v"(fr), "+v"(fq));
        PG8_LAS f32x4* X = (PG8_LAS f32x4*)(lds + XCH_OFF);
        const int lane = fr + 16 * fq;
        if (fr >= 14) {
#pragma unroll
            for (int ai = 0; ai < 2; ++ai)
#pragma unroll
                for (int bj = 0; bj < 2; ++bj)
#pragma unroll
                    for (int n = 0; n < 2; ++n) X[((((((ai * 2 + wr) * 2 + (fr - 14)) * 4 + wc) * 2 + bj) * 2 + n) * 4) + fq] = acc[ai][bj][3][n];
        }
        asm volatile("s_waitcnt lgkmcnt(0)" ::: "memory"); __builtin_amdgcn_s_barrier(); asm volatile("" ::: "memory");
        const int b = u.pm / FT, it = u.pm % FT;
#pragma unroll
        for (int n = 0; n < 2; ++n) {
            const int gc = 128 * u.pn + 32 * wc + 8 * fq + 4 * n;
            const f32x4 wg0 = *(const f32x4*)(cw + gc), wg1 = *(const f32x4*)(cw + FFN2 + gc), wg2 = *(const f32x4*)(cw + 2 * FFN2 + gc), bg = *(const f32x4*)(cb + gc);
            const f32x4 wv0 = *(const f32x4*)(cw + FFN + gc), wv1 = *(const f32x4*)(cw + FFN2 + FFN + gc), wv2 = *(const f32x4*)(cw + 2 * FFN2 + FFN + gc), bv = *(const f32x4*)(cb + FFN + gc);
#pragma unroll
            for (int ai = 0; ai < 2; ++ai) {
                const int G = ai * 2 + wr;
                f32x4 pg = (f32x4){0.f, 0.f, 0.f, 0.f}, pv = pg;
                if (G > 0) {
                    const int rr = (fr == 15) ? 1 : 0;
                    pg = X[((((((G - 1) * 2 + rr) * 4 + wc) * 2 + 0) * 2 + n) * 4) + fq];
                    pv = X[((((((G - 1) * 2 + rr) * 4 + wc) * 2 + 1) * 2 + n) * 4) + fq];
                }
                float g_r1[4], g_r2[4], v_r1[4], v_r2[4];
#pragma unroll
                for (int e = 0; e < 4; ++e) { g_r1[e] = dpp_ror<1>(pg[e]); g_r2[e] = dpp_ror<2>(pg[e]); v_r1[e] = dpp_ror<1>(pv[e]); v_r2[e] = dpp_ror<2>(pv[e]); }
#pragma unroll
                for (int m = 0; m < 4; ++m) {
                    const f32x4 cg = acc[ai][0][m][n], cv = acc[ai][1][m][n];
                    float o[4];
#pragma unroll
                    for (int e = 0; e < 4; ++e) {
                        const float g1 = dpp_shr_keep<1>(g_r1[e], cg[e]), g2 = dpp_shr_keep<2>(g_r2[e], cg[e]);
                        const float v1 = dpp_shr_keep<1>(v_r1[e], cv[e]), v2 = dpp_shr_keep<2>(v_r2[e], cv[e]);
                        if (m < 3) { g_r1[e] = dpp_ror<1>(cg[e]); g_r2[e] = dpp_ror<2>(cg[e]); v_r1[e] = dpp_ror<1>(cv[e]); v_r2[e] = dpp_ror<2>(cv[e]); }
                        const float yg = bg[e] + wg0[e] * g2 + wg1[e] * g1 + wg2[e] * cg[e];
                        const float yv = bv[e] + wv0[e] * v2 + wv1[e] * v1 + wv2[e] * cv[e];
                        const float sg = yg * __builtin_amdgcn_rcpf(1.0f + __builtin_amdgcn_exp2f(-yg * LOG2E));
                        o[e] = sg * yv;
                    }
                    const int R = ai * HALF + wr * 64 + m * 16 + fr, tok = 254 * it - 2 + R;
                    if (R >= 2 && tok < SEQ) { u32x2 w; w.x = cvt_pk_bf16(o[0], o[1]); w.y = cvt_pk_bf16(o[2], o[3]);
                        *(u32x2*)(act + ((size_t)b * SEQ + tok) * FFN + gc) = w; }
                }
            }
        }
    }
};
struct EpiLatDown {
    static constexpr bool PERM = false;
    bf16_t* ckv; bf16_t* cq; bf16_t* kr; float* ssqkv; float* ssqq; const float* cosT; const float* sinT;
    __device__ __forceinline__ void operator()(AccRef acc, const Unit& u, int wr, int wc, int fr_in, int fq_in, PG8_LAS unsigned char*) const {
        int fr = fr_in, fq = fq_in; asm volatile("" : "+v"(fr), "+v"(fq));
        const int row0 = u.pm * BM + wr * 64 + fr, cl = wc * 32 + 4 * fq;
        if (u.pn == 1) {
            if (wc == 0) {
#pragma unroll
                for (int ai = 0; ai < 2; ++ai)
#pragma unroll
                    for (int m = 0; m < 4; ++m) { const int row = row0 + ai * HALF + m * 16;
                        const f32x4 c = *(const f32x4*)(cosT + (size_t)row * 16 + 4 * fq), s = *(const f32x4*)(sinT + (size_t)row * 16 + 4 * fq);
                        const f32x4 t1 = acc[ai][0][m][0], t2 = acc[ai][0][m][1];
                        const f32x4 o1 = t1 * c - t2 * s, o2 = t2 * c + t1 * s;
                        u32x2 w1, w2; w1.x = cvt_pk_bf16(o1[0], o1[1]); w1.y = cvt_pk_bf16(o1[2], o1[3]); w2.x = cvt_pk_bf16(o2[0], o2[1]); w2.y = cvt_pk_bf16(o2[2], o2[3]);
                        *(u32x2*)(kr + (size_t)row * ROPE + 4 * fq) = w1; *(u32x2*)(kr + (size_t)row * ROPE + 16 + 4 * fq) = w2; }
            }
            return;
        }
        const bool isq = u.pn >= 2; const int cbase = isq ? (u.pn - 2) * 256 : 0, ld = isq ? QL : KVL; bf16_t* O = isq ? cq : ckv;
#pragma unroll
        for (int ai = 0; ai < 2; ++ai)
#pragma unroll
            for (int m = 0; m < 4; ++m) { const int row = row0 + ai * HALF + m * 16; float ss = 0.f;
#pragma unroll
                for (int bj = 0; bj < 2; ++bj)
#pragma unroll
                    for (int n = 0; n < 2; ++n) { const f32x4 v = acc[ai][bj][m][n]; ss += (v[0] * v[0] + v[1] * v[1]) + (v[2] * v[2] + v[3] * v[3]);
                        const int c = cbase + bj * HALF + cl + n * 16;
                        if (c < ld) { u32x2 w; w.x = cvt_pk_bf16(v[0], v[1]); w.y = cvt_pk_bf16(v[2], v[3]); *(u32x2*)(O + (size_t)row * ld + c) = w; } }
                ss += lane_read(ss, (fr + 16 * fq) ^ 16); ss += lane_read(ss, (fr + 16 * fq) ^ 32);
                if (fq == 0) { if (isq) ssqq[(size_t)row * 8 + (u.pn - 2) * 4 + wc] = ss; else ssqkv[(size_t)row * 4 + wc] = ss; } }
    }
};
template <bool ISQ> struct EpiLatUp {
    static constexpr bool PERM = false;
    bf16_t* O0; bf16_t* O1; const float* ssq; const float* cosT; const float* sinT;
    __device__ __forceinline__ void operator()(AccRef acc, const Unit& u, int wr, int wc, int fr_in, int fq_in, PG8_LAS unsigned char*) const {
        int fr = fr_in, fq = fq_in; asm volatile("" : "+v"(fr), "+v"(fq));
        const int row0 = u.pm * BM + wr * 64 + fr, cl = wc * 32 + 4 * fq;
        const bool second = u.pn >= 4; const int ct = (second ? u.pn - 4 : u.pn) * 256; bf16_t* O = second ? O1 : O0; constexpr int ld = DM;
#pragma unroll
        for (int ai = 0; ai < 2; ++ai)
#pragma unroll
            for (int m = 0; m < 4; ++m) { const int row = row0 + ai * HALF + m * 16; float rs;
                if (ISQ) { const f32x4 a = *(const f32x4*)(ssq + (size_t)row * 8), b2 = *(const f32x4*)(ssq + (size_t)row * 8 + 4);
                    rs = __builtin_amdgcn_rsqf((((a[0] + a[1]) + (a[2] + a[3])) + ((b2[0] + b2[1]) + (b2[2] + b2[3]))) * (1.0f / QL) + EPS) * QS_B; }
                else { const f32x4 a = *(const f32x4*)(ssq + (size_t)row * 4); rs = __builtin_amdgcn_rsqf(((a[0] + a[1]) + (a[2] + a[3])) * (1.0f / KVL) + EPS); }
                asm volatile("" : "+v"(rs) :: "memory");
                if (ISQ && second) {
                    const f32x4 c = *(const f32x4*)(cosT + (size_t)row * 16 + 4 * fq), s = *(const f32x4*)(sinT + (size_t)row * 16 + 4 * fq);
#pragma unroll
                    for (int bj = 0; bj < 2; ++bj) { const f32x4 t1 = acc[ai][bj][m][0] * rs, t2 = acc[ai][bj][m][1] * rs;
                        const f32x4 o1 = t1 * c - t2 * s, o2 = t2 * c + t1 * s;
                        u32x2 w1, w2; w1.x = cvt_pk_bf16(o1[0], o1[1]); w1.y = cvt_pk_bf16(o1[2], o1[3]); w2.x = cvt_pk_bf16(o2[0], o2[1]); w2.y = cvt_pk_bf16(o2[2], o2[3]);
                        bf16_t* p = O + (size_t)row * ld + ct + bj * HALF + cl; *(u32x2*)p = w1; *(u32x2*)(p + 16) = w2; asm volatile("" ::: "memory"); }
                } else {
#pragma unroll
                    for (int bj = 0; bj < 2; ++bj)
#pragma unroll
                        for (int n = 0; n < 2; ++n) { const f32x4 v = acc[ai][bj][m][n] * rs; u32x2 w; w.x = cvt_pk_bf16(v[0], v[1]); w.y = cvt_pk_bf16(v[2], v[3]);
                            *(u32x2*)(O + (size_t)row * ld + ct + bj * HALF + cl + n * 16) = w; }
                }
                asm volatile("" ::: "memory"); }
    }
};
template <class Epi, class Sched, bool ALIGN_EPI = false, bool SP2 = false>
__device__ __forceinline__ void gemm_phase(PG8_LAS unsigned char* lds, const int K, const Sched& S, const Epi& E) {
    int tid_ = threadIdx.x; asm volatile("" : "+v"(tid_));
    const int tid = tid_, wid = __builtin_amdgcn_readfirstlane(tid >> 6), lane = tid & 63, wr = wid >> 2, wc = wid & 3, fr = lane & 15, fq = lane >> 4;
    const int nt = K / BK;
    unsigned voffA[2], voffB[2];
#pragma unroll
    for (int i = 0; i < 2; ++i) { int R, C; stage_rc(tid * 16 + i * 8192, R, C); const int Rb = Epi::PERM ? ((R & ~31) + perm32(R & 31)) : R;
        voffA[i] = (unsigned)(R * K + C) * 2u; voffB[i] = (unsigned)(Rb * K + C) * 2u; }
    const size_t kstep = (size_t)(BK * 2);
    const size_t hstep = (size_t)HALF * K * 2;
    const unsigned ldsw = (unsigned)wid * 1024u;
    const int aoff = lds_byte(wr * 64 + fr, fq * 8), boff = lds_byte(wc * 32 + fr, fq * 8);
#define PG8_SA(b, h) (((b) * 2 + (h)) * HTB)
#define PG8_SB(b, h) ((4 + (b) * 2 + (h)) * HTB)
#define PG8_STAGE(bufoff, gbase, voff) do { _Pragma("unroll") for (int _i = 0; _i < 2; ++_i) \
        __builtin_amdgcn_global_load_lds((const unsigned*)((const char*)(gbase) + (voff)[_i]), (PG8_LAS unsigned*)(lds + (bufoff) + ldsw + _i * 8192), 16, 0, 0); } while (0)
#define PG8_LDA(dst, b, h) do { _Pragma("unroll") for (int m = 0; m < 4; ++m) _Pragma("unroll") for (int k = 0; k < 2; ++k) dst[m][k] = *(const PG8_LAS bf16x8*)(lds + PG8_SA(b, h) + aoff + m * 2048 + k * 1024); } while (0)
#define PG8_LDB(dst, b, h) do { _Pragma("unroll") for (int n = 0; n < 2; ++n) _Pragma("unroll") for (int k = 0; k < 2; ++k) dst[n][k] = *(const PG8_LAS bf16x8*)(lds + PG8_SB(b, h) + boff + n * 2048 + k * 1024); } while (0)
#define PG8_MMA(ai, bj, At, Bt) do { __builtin_amdgcn_s_setprio(1); _Pragma("unroll") for (int m = 0; m < 4; ++m) _Pragma("unroll") for (int n = 0; n < 2; ++n) _Pragma("unroll") for (int k = 0; k < 2; ++k) \
        acc[ai][bj][m][n] = __builtin_amdgcn_mfma_f32_16x16x32_bf16(Bt[n][k], At[m][k], acc[ai][bj][m][n], 0, 0, 0); __builtin_amdgcn_s_setprio(0); } while (0)
#define PG8_WAIT_V(n) asm volatile("s_waitcnt vmcnt(" #n ")" ::: "memory")
#define PG8_WAIT_L(n) asm volatile("s_waitcnt lgkmcnt(" #n ")" ::: "memory")
#define PG8_BAR __builtin_amdgcn_s_barrier()
#define PG8_SCHED __builtin_amdgcn_sched_barrier(0)
    Unit cur, nxt; int ui = 0;
    if (!S.next(0, cur)) return;
    f32x4 acc[2][2][4][2];
#pragma unroll
    for (int a = 0; a < 2; ++a)
#pragma unroll
        for (int b = 0; b < 2; ++b)
#pragma unroll
            for (int m = 0; m < 4; ++m)
#pragma unroll
                for (int n = 0; n < 2; ++n) acc[a][b][m][n] = (f32x4){0.f, 0.f, 0.f, 0.f};
    bf16x8 At[4][2], B0[2][2], B1[2][2];
    const char* cA = S.abase(cur); const char* cB = S.bbase(cur);
    if constexpr (SP2) {
        PG8_STAGE(PG8_SB(0, 0), cB, voffB); PG8_STAGE(PG8_SB(0, 1), cB + hstep, voffB); PG8_STAGE(PG8_SA(0, 0), cA, voffA); PG8_STAGE(PG8_SA(0, 1), cA + hstep, voffA);
        if (wr == 1) PG8_BAR;
        PG8_WAIT_V(2); PG8_BAR;
        PG8_STAGE(PG8_SB(1, 0), cB + kstep, voffB); PG8_STAGE(PG8_SA(1, 0), cA + kstep, voffA); PG8_STAGE(PG8_SB(1, 1), cB + hstep + kstep, voffB);
        PG8_WAIT_V(6); PG8_BAR;
    } else {
        PG8_STAGE(PG8_SB(0, 0), cB, voffB); PG8_STAGE(PG8_SA(0, 0), cA, voffA); PG8_STAGE(PG8_SB(0, 1), cB + hstep, voffB); PG8_STAGE(PG8_SA(0, 1), cA + hstep, voffA);
        if (wr == 1) PG8_BAR;
        PG8_WAIT_V(4); PG8_BAR;
        PG8_STAGE(PG8_SB(1, 0), cB + kstep, voffB); PG8_STAGE(PG8_SA(1, 0), cA + kstep, voffA); PG8_STAGE(PG8_SB(1, 1), cB + hstep + kstep, voffB);
        PG8_WAIT_V(6); PG8_BAR;
    }
    for (;;) {
        const bool has_next = S.next(ui + 1, nxt);
        const char* nA = has_next ? S.abase(nxt) : cA; const char* nB = has_next ? S.bbase(nxt) : cB;
        for (int t = 0; t < nt; t += 2) {
            const bool last = (t == nt - 2);
            const char* a1 = cA + (size_t)(t + 1) * kstep;
            const char* a2 = last ? nA : cA + (size_t)(t + 2) * kstep; const char* b2 = last ? nB : cB + (size_t)(t + 2) * kstep;
            const char* a3 = a2 + kstep; const char* b3 = b2 + kstep;
            if constexpr (SP2) {
            PG8_LDB(B0, 0, 0); PG8_LDB(B1, 0, 1); PG8_SCHED; PG8_LDA(At, 0, 0); PG8_STAGE(PG8_SA(1, 1), a1 + hstep, voffA);
            PG8_WAIT_V(8); PG8_WAIT_L(0); PG8_BAR; PG8_MMA(0, 0, At, B0); PG8_MMA(0, 1, At, B1); PG8_BAR; PG8_SCHED;
            PG8_LDA(At, 0, 1); PG8_STAGE(PG8_SB(0, 0), b2, voffB); PG8_STAGE(PG8_SB(0, 1), b2 + hstep, voffB); PG8_STAGE(PG8_SA(0, 0), a2, voffA);
            PG8_WAIT_V(8); PG8_WAIT_L(0); PG8_BAR; PG8_MMA(1, 0, At, B0); PG8_MMA(1, 1, At, B1); PG8_BAR; PG8_SCHED;
            PG8_LDB(B0, 1, 0); PG8_LDB(B1, 1, 1); PG8_SCHED; PG8_LDA(At, 1, 0); PG8_STAGE(PG8_SA(0, 1), a2 + hstep, voffA);
            PG8_WAIT_V(8); PG8_WAIT_L(0); PG8_BAR; PG8_MMA(0, 0, At, B0); PG8_MMA(0, 1, At, B1); PG8_BAR; PG8_SCHED;
            PG8_LDA(At, 1, 1); PG8_STAGE(PG8_SB(1, 0), b3, voffB); PG8_STAGE(PG8_SB(1, 1), b3 + hstep, voffB); PG8_STAGE(PG8_SA(1, 0), a3, voffA);
            PG8_WAIT_V(8); PG8_WAIT_L(0); PG8_BAR; PG8_MMA(1, 0, At, B0); PG8_MMA(1, 1, At, B1); PG8_BAR; PG8_SCHED;
            } else {
            PG8_LDB(B0, 0, 0); PG8_SCHED; PG8_LDA(At, 0, 0); PG8_STAGE(PG8_SA(1, 1), a1 + hstep, voffA);
            PG8_WAIT_L(8); PG8_BAR; PG8_WAIT_L(0); PG8_MMA(0, 0, At, B0); PG8_BAR; PG8_SCHED;
            PG8_LDB(B1, 0, 1); PG8_STAGE(PG8_SB(0, 0), b2, voffB);
            PG8_BAR; PG8_WAIT_L(0); PG8_MMA(0, 1, At, B1); PG8_BAR;
            PG8_LDA(At, 0, 1); PG8_STAGE(PG8_SA(0, 0), a2, voffA);
            PG8_BAR; PG8_WAIT_L(0); PG8_MMA(1, 0, At, B0); PG8_BAR; PG8_SCHED;
            PG8_STAGE(PG8_SB(0, 1), b2 + hstep, voffB);
            PG8_WAIT_V(6); PG8_BAR; PG8_MMA(1, 1, At, B1); PG8_BAR;
            PG8_LDB(B0, 1, 0); PG8_SCHED; PG8_LDA(At, 1, 0); PG8_STAGE(PG8_SA(0, 1), a2 + hstep, voffA);
            PG8_WAIT_L(8); PG8_BAR; PG8_WAIT_L(0); PG8_MMA(0, 0, At, B0); PG8_BAR; PG8_SCHED;
            PG8_LDB(B1, 1, 1); PG8_STAGE(PG8_SB(1, 0), b3, voffB);
            PG8_BAR; PG8_WAIT_L(0); PG8_MMA(0, 1, At, B1); PG8_BAR;
            PG8_LDA(At, 1, 1); PG8_STAGE(PG8_SA(1, 0), a3, voffA);
            PG8_BAR; PG8_WAIT_L(0); PG8_MMA(1, 0, At, B0); PG8_BAR; PG8_SCHED;
            PG8_STAGE(PG8_SB(1, 1), b3 + hstep, voffB);
            PG8_WAIT_V(6); PG8_BAR; PG8_MMA(1, 1, At, B1); PG8_BAR;
            }
        }
        if constexpr (ALIGN_EPI) { if (wr == 0) PG8_BAR; }
        E(acc, cur, wr, wc, fr, fq, lds);
        if (!has_next) break;
#pragma unroll
        for (int a = 0; a < 2; ++a)
#pragma unroll
            for (int b = 0; b < 2; ++b)
#pragma unroll
                for (int m = 0; m < 4; ++m)
#pragma unroll
                    for (int n = 0; n < 2; ++n) acc[a][b][m][n] = (f32x4){0.f, 0.f, 0.f, 0.f};
        cur = nxt; cA = nA; cB = nB; ++ui;
        if constexpr (ALIGN_EPI) { if (wr == 1) PG8_BAR; }
    }
    PG8_WAIT_V(0);
    if constexpr (!ALIGN_EPI) { if (wr == 0) PG8_BAR; }
    PG8_BAR;
#undef PG8_SA
#undef PG8_SB
#undef PG8_STAGE
#undef PG8_LDA
#undef PG8_LDB
#undef PG8_MMA
#undef PG8_WAIT_V
#undef PG8_WAIT_L
#undef PG8_BAR
#undef PG8_SCHED
}
}
namespace att {
__device__ __forceinline__ int crow(int r, int hi) { return (r & 3) + 8 * (r >> 2) + 4 * hi; }
typedef short v4i16_t __attribute__((ext_vector_type(4)));
__device__ __forceinline__ s16x4 vtr(const LAS unsigned char* p) { return __builtin_bit_cast(s16x4, __builtin_amdgcn_ds_read_tr16_b64_v4i16((LAS v4i16_t*)p)); }
#define MFMA32(a, b, c) __builtin_amdgcn_mfma_f32_32x32x16_bf16((a), (b), (c), 0, 0, 0)

template <int DQK, bool BIAS, int NB>
__device__ __forceinline__ void attn_unit(LAS unsigned char* lds, int b, int h, int q0, const bf16_t* Qn, const bf16_t* Qr, const bf16_t* Kn, const bf16_t* Kr,
                                          const bf16_t* Vg, bf16_t* Og, const float* biasg) {
    constexpr int NC = DQK / 8, KSZ = NC * 1024, ND = DQK / 16;
    constexpr int OFF_V = 2 * KSZ, OFF_WSF = OFF_V + 16384, OFF_BT = OFF_WSF + 8 * 64 * NB * 4;
    int tid_ = threadIdx.x; asm volatile("" : "+v"(tid_));
    const int tid = tid_, lane = tid & 63, r32 = lane & 31, hi = lane >> 5; const int wid = __builtin_amdgcn_readfirstlane(tid >> 6);
    const size_t rowbase = (size_t)b * SEQ;
    const int qw = q0 + wid * 32 * NB;
    const int cwv = qw >> 6, c0 = q0 >> 6;
    const int tlo = BIAS ? (c0 - 8 > 0 ? c0 - 8 : 0) : 0, thi = c0 + 4 * NB;
    const int wlo = BIAS ? (cwv - 8 > 0 ? cwv - 8 : 0) : 0, whi = cwv;
    LAS float* wsf = (LAS float*)(lds + OFF_WSF) + wid * 64 * NB;
    LAS float* bt = (LAS float*)(lds + OFF_BT);
    bf16x8 qf[NB][ND];
#pragma unroll
    for (int nb = 0; nb < NB; ++nb) {
        const size_t qrow = rowbase + qw + nb * 32 + r32;
#pragma unroll
        for (int d0 = 0; d0 < 4; ++d0) qf[nb][d0] = *(const bf16x8*)(Qn + qrow * DM + h * 64 + d0 * 16 + hi * 8);
        if constexpr (DQK == 96) {
#pragma unroll
            for (int d0 = 4; d0 < 6; ++d0) qf[nb][d0] = *(const bf16x8*)(Qr + qrow * DM + h * 32 + (d0 - 4) * 16 + hi * 8);
        }
    }
    if constexpr (BIAS) { for (int i = tid; i < 257; i += 512) bt[i] = biasg[i] * LOG2E; }
    const int ka_key = tid / NC, ka_c = tid % NC, kb_key = (tid + 512) / NC, kb_c = (tid + 512) % NC, v_key = tid >> 3, v_c = tid & 7;
    const bool has_kb = (DQK == 96) && (tid < 256);
    const int ka_dst = ka_c * 1024 + ka_key * 16, kb_dst = kb_c * 1024 + kb_key * 16;
    const int v_dst = (v_c >> 2) * 4096 + (v_key >> 4) * 1024 + (v_key & 15) * 64 + (v_c & 3) * 16;
    const bf16_t* pa_src = (ka_c < 8) ? Kn + (rowbase + ka_key) * DM + h * 64 + ka_c * 8 : Kr + (rowbase + ka_key) * ROPE + (ka_c - 8) * 8;
    const bf16_t* pb_src = (kb_c < 8) ? Kn + (rowbase + kb_key) * DM + h * 64 + kb_c * 8 : Kr + (rowbase + kb_key) * ROPE + (kb_c - 8) * 8;
    const int pa_step = (ka_c < 8) ? 64 * DM : 64 * ROPE, pb_step = (kb_c < 8) ? 64 * DM : 64 * ROPE;
    const bf16_t* pv_src = Vg + (rowbase + v_key) * DM + h * 64 + v_c * 8;
    u32x4 ra, rb, rv;
#define ATT_LOAD(t) do { ra = *(const u32x4*)(pa_src + (size_t)(t) * pa_step); if (has_kb) rb = *(const u32x4*)(pb_src + (size_t)(t) * pb_step); rv = *(const u32x4*)(pv_src + (size_t)(t) * 64 * DM); } while (0)
#define ATT_STORE(buf) do { *(LAS u32x4*)(lds + (buf) * KSZ + ka_dst) = ra; if (has_kb) *(LAS u32x4*)(lds + (buf) * KSZ + kb_dst) = rb; \
        *(LAS u32x4*)(lds + OFF_V + (buf) * 8192 + v_dst) = rv; } while (0)
    rb = (u32x4){0u, 0u, 0u, 0u};
    ATT_LOAD(tlo); ATT_STORE(0);
    __syncthreads();
    float mrun[NB], lrun[NB]; f32x16 o0[NB], o1[NB];
#pragma unroll
    for (int nb = 0; nb < NB; ++nb) { mrun[nb] = 0.f; lrun[nb] = 0.f; o0[nb] = (f32x16){}; o1[nb] = (f32x16){}; }
    const int vrd = (4 * hi + ((lane & 15) >> 2)) * 64 + ((lane >> 4) & 1) * 32 + (lane & 3) * 8;
    for (int t = tlo; t < thi; ++t) {
        const int cur = (t - tlo) & 1;
        const bool more = (t + 1 < thi);
        if (more) ATT_LOAD(t + 1);
        if (t >= wlo && t <= whi) {
            const LAS unsigned char* Kb = lds + cur * KSZ + hi * 1024 + r32 * 16;
            const LAS unsigned char* Vb = lds + OFF_V + cur * 8192 + vrd;
            f32x16 p0[NB], p1[NB];
#pragma unroll
            for (int nb = 0; nb < NB; ++nb) { p0[nb] = (f32x16){}; p1[nb] = (f32x16){}; }
            {
                bf16x8 k0 = *(const LAS bf16x8*)(Kb), k1 = *(const LAS bf16x8*)(Kb + 512);
#pragma unroll
                for (int d0 = 0; d0 < ND; ++d0) {
                    bf16x8 n0 = k0, n1 = k1;
                    if (d0 + 1 < ND) { n0 = *(const LAS bf16x8*)(Kb + (d0 + 1) * 2048); n1 = *(const LAS bf16x8*)(Kb + (d0 + 1) * 2048 + 512); }
                    __builtin_amdgcn_sched_barrier(0);
#pragma unroll
                    for (int nb = 0; nb < NB; ++nb) { p0[nb] = MFMA32(k0, qf[nb][d0], p0[nb]); p1[nb] = MFMA32(k1, qf[nb][d0], p1[nb]); }
                    __builtin_amdgcn_sched_barrier(0);
                    k0 = n0; k1 = n1;
                }
            }
            u32x4 pw[NB][4];
#pragma unroll
            for (int nb = 0; nb < NB; ++nb) {
                if constexpr (BIAS) {
                    const int dbase = qw + nb * 32 - t * 64;
                    if (dbase - 63 >= 128) { const float cb = bt[256];
#pragma unroll
                        for (int i = 0; i < 16; ++i) { p0[nb][i] += cb; p1[nb][i] += cb; } }
                    else {
#pragma unroll
                        for (int i = 0; i < 16; ++i) { const int d = dbase + r32 - crow(i, hi); const int i0 = (d < 128 ? d : 128) + 128, i1 = (d - 32 < 128 ? d - 32 : 128) + 128;
                            p0[nb][i] += bt[i0]; p1[nb][i] += bt[i1]; }
                    }
                }
                float ra_ = fmaxf(fmaxf(p0[nb][0], p1[nb][0]), p0[nb][1]), rb_ = fmaxf(fmaxf(p1[nb][1], p0[nb][2]), p1[nb][2]);
#pragma unroll
                for (int i = 3; i < 15; i += 2) { ra_ = fmaxf(fmaxf(ra_, p0[nb][i]), p1[nb][i]); rb_ = fmaxf(fmaxf(rb_, p0[nb][i + 1]), p1[nb][i + 1]); }
                float rm = fmaxf(fmaxf(ra_, rb_), fmaxf(p0[nb][15], p1[nb][15]));
                rm = fmaxf(rm, lane_read(rm, lane ^ 32));
                if (t == wlo) { mrun[nb] = rm; }
                else if (__any(rm > mrun[nb] + 8.0f)) {
                    const float dl = fmaxf(rm - mrun[nb], 0.f); const float al = __builtin_amdgcn_exp2f(-dl); mrun[nb] += dl; lrun[nb] *= al;
                    if (hi == 0) wsf[nb * 64 + r32] = al;
#pragma unroll
                    for (int i = 0; i < 16; ++i) { const float a = wsf[nb * 64 + crow(i, hi)]; o0[nb][i] *= a; o1[nb][i] *= a; }
                }
                float ls0 = 0.f, ls1 = 0.f; const float mm = mrun[nb];
#pragma unroll
                for (int i = 0; i < 16; ++i) { p0[nb][i] = __builtin_amdgcn_exp2f(p0[nb][i] - mm); p1[nb][i] = __builtin_amdgcn_exp2f(p1[nb][i] - mm); ls0 += p0[nb][i]; ls1 += p1[nb][i]; }
                lrun[nb] += ls0 + ls1;
#pragma unroll
                for (int k = 0; k < 4; ++k) { pw[nb][0][k] = cvt_pk_bf16(p0[nb][2 * k], p0[nb][2 * k + 1]); pw[nb][1][k] = cvt_pk_bf16(p0[nb][8 + 2 * k], p0[nb][8 + 2 * k + 1]);
                    pw[nb][2][k] = cvt_pk_bf16(p1[nb][2 * k], p1[nb][2 * k + 1]); pw[nb][3][k] = cvt_pk_bf16(p1[nb][8 + 2 * k], p1[nb][8 + 2 * k + 1]); }
            }
            {
                s16x4 a0 = vtr(Vb), a1 = vtr(Vb + 512), c0_ = vtr(Vb + 4096), c1_ = vtr(Vb + 4096 + 512);
#pragma unroll
                for (int ks = 0; ks < 4; ++ks) {
                    const bf16x8 v0 = (bf16x8){a0[0], a0[1], a0[2], a0[3], a1[0], a1[1], a1[2], a1[3]}, v1 = (bf16x8){c0_[0], c0_[1], c0_[2], c0_[3], c1_[0], c1_[1], c1_[2], c1_[3]};
                    if (ks + 1 < 4) { a0 = vtr(Vb + (ks + 1) * 1024); a1 = vtr(Vb + (ks + 1) * 1024 + 512); c0_ = vtr(Vb + 4096 + (ks + 1) * 1024); c1_ = vtr(Vb + 4096 + (ks + 1) * 1024 + 512); }
                    __builtin_amdgcn_sched_barrier(0);
#pragma unroll
                    for (int nb = 0; nb < NB; ++nb) { const bf16x8 pa = __builtin_bit_cast(bf16x8, pw[nb][ks]); o0[nb] = MFMA32(pa, v0, o0[nb]); o1[nb] = MFMA32(pa, v1, o1[nb]); }
                    __builtin_amdgcn_sched_barrier(0);
                }
            }
        }
        if (more) ATT_STORE(cur ^ 1);
        __syncthreads();
    }
#undef ATT_LOAD
#undef ATT_STORE
#pragma unroll
    for (int nb = 0; nb < NB; ++nb) {
        float lt = lrun[nb]; lt += lane_read(lt, lane ^ 32);
        if (hi == 0) wsf[nb * 64 + 32 + r32] = lt;
        bf16_t* Ow = Og + (rowbase + qw + nb * 32) * DM + h * 64 + r32;
#pragma unroll
        for (int i = 0; i < 16; ++i) { const int q = crow(i, hi); const float rl = __builtin_amdgcn_rcpf(wsf[nb * 64 + 32 + q]);
            const unsigned w0 = cvt_pk_bf16(o0[nb][i] * rl, 0.f), w1 = cvt_pk_bf16(o1[nb][i] * rl, 0.f);
            Ow[(size_t)q * DM] = (bf16_t)(w0 & 0xffffu); Ow[(size_t)q * DM + 32] = (bf16_t)(w1 & 0xffffu); }
    }
    __syncthreads();
}
#undef MFMA32
}
__device__ const float INV_FREQ[16] = {1.000000000e+00f, 5.623413324e-01f, 3.162277639e-01f, 1.778279394e-01f, 1.000000015e-01f, 5.623413250e-02f, 3.162277490e-02f, 1.778279431e-02f,
                                       9.999999776e-03f, 5.623413250e-03f, 3.162277630e-03f, 1.778279431e-03f, 1.000000047e-03f, 5.623413017e-04f, 3.162277571e-04f, 1.778279402e-04f};
__device__ __forceinline__ unsigned f2bf(float f) { unsigned u = __builtin_bit_cast(unsigned, f); return (u + 0x7fffu + ((u >> 16) & 1u)) >> 16; }
__device__ __forceinline__ unsigned pk2(float lo, float hi) { return f2bf(lo) | (f2bf(hi) << 16); }

struct Params { const void* in[28]; float* out; unsigned char* ws; };
__device__ __forceinline__ const void* karg(int i) { int z = 0; asm volatile("" : "+s"(z)); const void* const* kp = (const void* const*)__builtin_amdgcn_kernarg_segment_ptr(); return kp[i + z]; }
#define KIN(i) ((const float*)karg(i))
#define KOUT ((float*)karg(28))
#define KWS(off) ((unsigned char*)karg(29) + (off))

__device__ __forceinline__ void transpose_item(const float* W, int K, int N, bf16_t* WT, int mode, int row_off, const float* kscale, LAS float* scr, int item, int lane) {
    const int nblk = N / 32, kb = item / nblk, nb = item % nblk, k0 = 64 * kb, n0 = 32 * nb;
#pragma unroll 8
    for (int i = 0; i < 32; ++i) { const int kk = 2 * i + (lane >> 5); float v = W[(size_t)(k0 + kk) * N + n0 + (lane & 31)]; if (kscale) v *= kscale[k0 + kk]; scr[kk * 33 + (lane & 31)] = v; }
    asm volatile("s_waitcnt lgkmcnt(0)" ::: "memory");
    const int c = lane & 7;
#pragma unroll
    for (int j = 0; j < 4; ++j) { const int n = (lane >> 3) + 8 * j; const LAS float* s = scr + (8 * c) * 33 + n;
        u32x4 o; o.x = pk2(s[0 * 33], s[1 * 33]); o.y = pk2(s[2 * 33], s[3 * 33]); o.z = pk2(s[4 * 33], s[5 * 33]); o.w = pk2(s[6 * 33], s[7 * 33]);
        const int nn = n0 + n; int drow;
        if (mode == 0) drow = row_off + nn; else { const int jj = nn < FFN ? nn : nn - FFN; drow = 256 * (jj >> 7) + (nn < FFN ? 0 : 128) + (jj & 127); }
        *(u32x4*)(WT + (size_t)drow * K + k0 + 8 * c) = o; }
    asm volatile("s_waitcnt lgkmcnt(0)" ::: "memory");
}

__device__ __forceinline__ void p0_prologue(LAS unsigned char* lds, int G, int bx) {
    int tid_ = threadIdx.x; asm volatile("" : "+v"(tid_));
    const int tid = tid_, lane = tid & 63; const int wid = __builtin_amdgcn_readfirstlane(tid >> 6);
    unsigned char* ws = KWS(0);
    float* modv = (float*)(ws + WS_MODV);
    {
        LAS float* ca = (LAS float*)lds; LAS float* red = ca + 2048;
        const float* c = KIN(1);
        for (int i = tid; i < 2048; i += 512) { const float v = c[i]; ca[i] = v / (1.0f + __expf(-v)); }
        __syncthreads();
        for (int item = bx; item < 224; item += G) {
            const int col = item * 64; const float* W; const float* bias; float* out; int N, ostride;
            if (col < 12288) { const int l = col / 6144, cc = col % 6144; W = KIN(3) + (size_t)l * 1024 * 6144 + cc; N = 6144; bias = KIN(4) + l * 6144 + cc; out = modv + (size_t)l * 2 * 6144 + cc; ostride = 6144; }
            else { const int cc = col - 12288; W = KIN(10) + cc; N = 2048; bias = KIN(11) + cc; out = modv + 24576 + cc; ostride = 2048; }
            float a0 = 0.f, a1 = 0.f; const int kb = wid * 128;
#pragma unroll 16
            for (int k = 0; k < 128; ++k) { const float w = W[(size_t)(kb + k) * N + lane]; a0 += ca[kb + k] * w; a1 += ca[1024 + kb + k] * w; }
            red[(wid * 2 + 0) * 64 + lane] = a0; red[(wid * 2 + 1) * 64 + lane] = a1;
            __syncthreads();
            if (tid < 128) { const int bb = tid >> 6, ln = tid & 63; float s = 0.f;
#pragma unroll
                for (int w = 0; w < 8; ++w) s += red[(w * 2 + bb) * 64 + ln];
                out[(size_t)bb * ostride + ln] = s + bias[ln]; }
            __syncthreads();
        }
    }
    __syncthreads();
    {
        LAS float* scr = (LAS float*)(lds + wid * 16384);
        const int gw = bx * 8 + wid, NGW = G * 8;
        bf16_t* WQKV = (bf16_t*)(ws + WS_WQKV); bf16_t* WO = (bf16_t*)(ws + WS_WO); bf16_t* WIN = (bf16_t*)(ws + WS_WIN); bf16_t* WOUT = (bf16_t*)(ws + WS_WOUT);
        bf16_t* WLD = (bf16_t*)(ws + WS_WLD); bf16_t* WKVUP = (bf16_t*)(ws + WS_WKVUP); bf16_t* WQUP = (bf16_t*)(ws + WS_WQUP); bf16_t* BWO = (bf16_t*)(ws + WS_BWO);
        constexpr int NITEMS = 1536 + 512 + 2 * 2816 + 2 * 1408 + 128 + 16 + 192 + 128 + 128 + 192 + 96 + 512;
        for (int it = gw; it < NITEMS; it += NGW) {
            int r = it;
            if (r < 1536) { transpose_item(KIN(7), 1024, 3072, WQKV, 0, 0, nullptr, scr, r, lane); continue; } r -= 1536;
            if (r < 512) { transpose_item(KIN(8), 1024, 1024, WO, 0, 0, nullptr, scr, r, lane); continue; } r -= 512;
            if (r < 5632) { const int l = r / 2816; transpose_item(KIN(23) + (size_t)l * 1024 * FFN2, 1024, FFN2, WIN + (size_t)l * FFN2 * 1024, 1, 0, nullptr, scr, r % 2816, lane); continue; } r -= 5632;
            if (r < 2816) { const int l = r / 1408; transpose_item(KIN(26) + (size_t)l * FFN * 1024, FFN, 1024, WOUT + (size_t)l * 1024 * FFN, 0, 0, nullptr, scr, r % 1408, lane); continue; } r -= 2816;
            if (r < 128) { transpose_item(KIN(13), 1024, 256, WLD, 0, 0, nullptr, scr, r, lane); continue; } r -= 128;
            if (r < 16) { transpose_item(KIN(17), 1024, 32, WLD, 0, 256, nullptr, scr, r, lane); continue; } r -= 16;
            if (r < 192) { transpose_item(KIN(18), 1024, 384, WLD, 0, 512, nullptr, scr, r, lane); continue; } r -= 192;
            if (r < 128) { transpose_item(KIN(15), 256, 1024, WKVUP, 0, 0, KIN(14), scr, r, lane); continue; } r -= 128;
            if (r < 128) { transpose_item(KIN(16), 256, 1024, WKVUP, 0, 1024, KIN(14), scr, r, lane); continue; } r -= 128;
            if (r < 192) { transpose_item(KIN(20), 384, 1024, WQUP, 0, 0, KIN(19), scr, r, lane); continue; } r -= 192;
            if (r < 96) { transpose_item(KIN(21), 384, 512, WQUP, 0, 1024, KIN(19), scr, r, lane); continue; } r -= 96;
            transpose_item(KIN(22), 1024, 1024, BWO, 0, 0, nullptr, scr, r, lane);
        }
        const int gt = bx * 512 + tid, NGT = G * 512;
        for (int i = gt; i < 352 * 128; i += NGT) { const int rr = i >> 7, piece = i & 127; const int row = rr < 224 ? 288 + rr : 896 + (rr - 224);
            *(u32x4*)(WLD + (size_t)row * 1024 + piece * 8) = (u32x4){0u, 0u, 0u, 0u}; }
        const int* pos = (const int*)karg(2); float* cosT = (float*)(ws + WS_COS); float* sinT = (float*)(ws + WS_SIN);
        for (int i = gt; i < T * 16; i += NGT) { const int t = i >> 4, j = i & 15; const float ang = (float)pos[t] * INV_FREQ[j];
            const double rev = (double)ang * 0.15915494309189535; const float fr = (float)(rev - rint(rev));
            cosT[i] = __builtin_amdgcn_cosf(fr); sinT[i] = __builtin_amdgcn_sinf(fr); }
    }
}

__device__ __forceinline__ float row_rstd(const float* xrow, int lane, f32x4 (&v)[4]) {
    float s = 0.f;
#pragma unroll
    for (int j = 0; j < 4; ++j) { v[j] = ((const f32x4*)xrow)[64 * j + lane]; s += (v[j].x * v[j].x + v[j].y * v[j].y) + (v[j].z * v[j].z + v[j].w * v[j].w); }
    return __builtin_amdgcn_rsqf(wave_sum(s, lane) * (1.0f / DM) + EPS);
}
__device__ __forceinline__ void mod_store(const f32x4 (&v)[4], float rstd, const float* g, const float* sh, const float* sc, bf16_t* orow, int lane) {
#pragma unroll
    for (int j = 0; j < 4; ++j) { const f32x4 gg = ((const f32x4*)g)[64 * j + lane], ss = ((const f32x4*)sh)[64 * j + lane], cc = ((const f32x4*)sc)[64 * j + lane];
        const f32x4 y = (v[j] * rstd * gg) * (cc + 1.0f) + ss;
        u32x2 w; w.x = cvt_pk_bf16(y.x, y.y); w.y = cvt_pk_bf16(y.z, y.w); ((u32x2*)orow)[64 * j + lane] = w; }
}
#define XB_TMO      128
#define XB_XCNT(j)  (256  + 64 * (j))
#define XB_XSUB(j)  (1280 + 64 * (j))
#define XB_XGEN(j)  (2304 + 64 * (j))
#define XB_TOP      3328
#define XB_TOPGEN   3392
#define XCD_BAR_WORDS 3456
#define XB_SPIN_CAP (1u << 18)

__device__ __forceinline__ unsigned xb_ld(unsigned* p)              { return __hip_atomic_load(p, __ATOMIC_RELAXED, __HIP_MEMORY_SCOPE_AGENT); }
__device__ __forceinline__ unsigned xb_add(unsigned* p, unsigned v) { return __hip_atomic_fetch_add(p, v, __ATOMIC_RELAXED, __HIP_MEMORY_SCOPE_AGENT); }
__device__ __forceinline__ unsigned xb_xcc_id() { return (unsigned)__builtin_amdgcn_s_getreg((3 << 11) | 20) & 0xFu; }
#define XB_SPIN(cond, bar) do { unsigned _sp = 0; while (cond) { __builtin_amdgcn_s_sleep(1); \
    if ((++_sp & 255u) == 0u) { if (xb_ld(&(bar)[XB_TMO])) break; if (_sp > XB_SPIN_CAP) { atomicAdd(&(bar)[XB_TMO], 1u); break; } } } } while (0)

struct XcdBarrier {
    unsigned* bar; unsigned x;
    volatile LAS unsigned* st;
};

__device__ __forceinline__ XcdBarrier xcd_barrier_post(unsigned* bar, volatile LAS unsigned* st) {
    XcdBarrier b; b.bar = bar; b.x = xb_xcc_id(); b.st = st;
    if (threadIdx.x == 0) (void)xb_add(&bar[XB_XCNT(b.x)], 1u);
    return b;
}
__device__ __forceinline__ void xcd_barrier_complete(unsigned* bar, unsigned x, unsigned& nloc, unsigned& nx) {
    const unsigned G = gridDim.x * gridDim.y * gridDim.z;
    unsigned sum, cnt, mine, sp = 0u;
    for (;;) {
        sum = 0u; cnt = 0u; mine = 0u;
#pragma unroll
        for (unsigned j = 0; j < 16; ++j) { const unsigned c = xb_ld(&bar[XB_XCNT(j)]); sum += c; cnt += (c > 0u) ? 1u : 0u; mine = (j == x) ? c : mine; }
        if (sum == G) break;
        __builtin_amdgcn_s_sleep(1);
        if ((++sp & 255u) == 0u) { if (xb_ld(&bar[XB_TMO])) break; if (sp > XB_SPIN_CAP) { atomicAdd(&bar[XB_TMO], 1u); break; } }
    }
    nloc = mine > 0u ? mine : 1u; nx = cnt > 0u ? cnt : 1u;
}

__device__ __forceinline__ void xcd_barrier(const XcdBarrier& b) {
    asm volatile("s_waitcnt vmcnt(0)" ::: "memory");
    __syncthreads();
    if (threadIdx.x == 0) {
        unsigned* bar = b.bar;
        __builtin_amdgcn_s_waitcnt(0);
        unsigned nloc = b.st[0], nx = b.st[1];
        if (nloc == 0u) { xcd_barrier_complete(bar, b.x, nloc, nx); b.st[0] = nloc; b.st[1] = nx; }
        const unsigned old = xb_add(&bar[XB_XSUB(b.x)], 1u);
        const unsigned gen = old / nloc;
        if (old + 1u == (gen + 1u) * nloc) {
            __builtin_amdgcn_fence(__ATOMIC_RELEASE, "agent");
            asm volatile("s_waitcnt vmcnt(0)" ::: "memory");
            const unsigned og = xb_add(&bar[XB_TOP], 1u);
            const unsigned tg = og / nx;
            if (og + 1u == (tg + 1u) * nx) xb_add(&bar[XB_TOPGEN], 1u);
            else XB_SPIN(xb_ld(&bar[XB_TOPGEN]) == tg, bar);
            __builtin_amdgcn_fence(__ATOMIC_ACQUIRE, "agent");
            xb_add(&bar[XB_XGEN(b.x)], 1u);
            asm volatile("s_waitcnt vmcnt(0)" ::: "memory");
        } else {
            XB_SPIN(xb_ld(&bar[XB_XGEN(b.x)]) == gen, bar);
            __builtin_amdgcn_fence(__ATOMIC_ACQUIRE, "agent");
            asm volatile("s_waitcnt vmcnt(0)" ::: "memory");
        }
    }
    __syncthreads();
}

template <class Epi, class S_> __device__ __forceinline__ void run_gemm(LAS unsigned char* lds, int K, const S_& S, const Epi& E) { pg8::gemm_phase<Epi, S_, true, true>(lds, K, S, E); }

__global__ void __launch_bounds__(512) fwd_megakernel(Params P) {
    extern __shared__ __attribute__((aligned(16))) unsigned char lds_raw[];
    LAS unsigned char* lds = (LAS unsigned char*)lds_raw;
    cg::grid_group grid = cg::this_grid();
    const int wid = __builtin_amdgcn_readfirstlane((int)threadIdx.x >> 6);
#define OPAQUE_LANE() unsigned om_ = ~0u; asm volatile("" : "+s"(om_)); int lane = __builtin_amdgcn_mbcnt_hi(om_, __builtin_amdgcn_mbcnt_lo(om_, 0u)); asm volatile("" : "+v"(lane))
#define OPAQUE_GRID() int G = G0, bx = bx0, gw = gw0, NGW = NGW0; asm volatile("" : "+s"(G), "+s"(bx), "+s"(gw), "+s"(NGW))
    const int G0 = gridDim.x, bx0 = blockIdx.x;
    const int gw0 = bx0 * 8 + wid, NGW0 = G0 * 8;
#define MODV ((float*)KWS(WS_MODV))
#define BF(off) ((bf16_t*)KWS(off))

    { unsigned* bw = (unsigned*)KWS(WS_BAR); if (bx0 == 0) for (int i = threadIdx.x; i < XCD_BAR_WORDS; i += 512) bw[i] = 0u;
      if (threadIdx.x < 2) ((volatile LAS unsigned*)(lds + MISC_OFF))[threadIdx.x] = 0u; }
    for (int rep = 0; rep < REP_P0; ++rep) { if (PH & 1) { OPAQUE_GRID(); (void)gw; (void)NGW; p0_prologue(lds, G, bx); } __syncthreads(); }
    grid.sync();
    const XcdBarrier xbar = xcd_barrier_post((unsigned*)KWS(WS_BAR), (volatile LAS unsigned*)(lds + MISC_OFF));
#define GRID_SYNC() xcd_barrier(xbar)
    for (int rep = 0; rep < EXTRA_SYNCS; ++rep) GRID_SYNC();

#pragma unroll 1
    for (int l = 0; l < 2; ++l) {
        if (l == 0) {
            { OPAQUE_LANE(); OPAQUE_GRID(); (void)G; (void)bx; const float* x = KIN(0); const float* modl = MODV; bf16_t* HN = BF(WS_HN); const float* g = KIN(5);
              for (int rep = 0; rep < REP_NORM1; ++rep)
              for (int m = gw; m < T; m += NGW) { const int b = m / SEQ; f32x4 v[4]; const float rstd = row_rstd(x + (size_t)m * DM, lane, v);
                mod_store(v, rstd, g, modl + b * 6144, modl + b * 6144 + 1024, HN + (size_t)m * DM, lane); } }
            GRID_SYNC();
            if (PH & 2) { OPAQUE_GRID(); (void)gw; (void)NGW; pg8::Sched<0> S; S.init(64, 12, 1024, KWS(WS_HN), nullptr, KWS(WS_WQKV), G, bx);
              pg8::EpiBf16 E{BF(WS_R1), DM, DM, (size_t)16 * 1024 * 1024, QS_A};
              for (int rep = 0; rep < REP_QKV; ++rep) run_gemm(lds, 1024, S, E); }
            GRID_SYNC();
            if (PH & 4) { OPAQUE_GRID(); (void)gw; (void)NGW; const bf16_t* R1 = BF(WS_R1); const bf16_t* R2 = BF(WS_R2); const bf16_t* R3 = BF(WS_R3); const float* rb = KIN(9);
              for (int rep = 0; rep < REP_ATTA; ++rep)
              for (int u = bx; u < 1024; u += G) { const int qb = u & 31, bh = u >> 5;
                att::attn_unit<64, true, 1>(lds, bh >> 4, bh & 15, qb * 256, R1, nullptr, R2, nullptr, R3, BF(WS_HN), rb + (bh & 15) * 257); } }
        } else {
            { OPAQUE_LANE(); OPAQUE_GRID(); (void)G; (void)bx; const float* out = KOUT; const float* modl = MODV + 2 * 6144; const float* kvmod = MODV + 24576; bf16_t* HN = BF(WS_HN); bf16_t* HN1 = BF(WS_HN1);
              const float* gkv = KIN(12); const float* g1 = KIN(5) + DM;
              for (int m = gw; m < T; m += NGW) { const int b = m / SEQ; f32x4 v[4]; const float rstd = row_rstd(out + (size_t)m * DM, lane, v);
                mod_store(v, rstd, gkv, kvmod + b * 2048, kvmod + b * 2048 + 1024, HN + (size_t)m * DM, lane);
                mod_store(v, rstd, g1, modl + b * 6144, modl + b * 6144 + 1024, HN1 + (size_t)m * DM, lane); } }
            GRID_SYNC();
            if (PH & 8) { OPAQUE_GRID(); (void)gw; (void)NGW; pg8::Sched<2> S; S.init(64, 4, 1024, KWS(WS_HN), KWS(WS_HN1), KWS(WS_WLD), G, bx);
              pg8::EpiLatDown E{BF(WS_CKV), BF(WS_CQ), BF(WS_KR), (float*)KWS(WS_SSQKV), (float*)KWS(WS_SSQQ), (const float*)KWS(WS_COS), (const float*)KWS(WS_SIN)}; run_gemm(lds, 1024, S, E); }
            GRID_SYNC();
            if (PH & 16) { OPAQUE_GRID(); (void)gw; (void)NGW; pg8::Sched<0> S; S.init(64, 8, KVL, KWS(WS_CKV), nullptr, KWS(WS_WKVUP), G, bx);
              pg8::EpiLatUp<false> E{BF(WS_R2), BF(WS_R3), (const float*)KWS(WS_SSQKV), (const float*)KWS(WS_COS), (const float*)KWS(WS_SIN)}; run_gemm(lds, KVL, S, E); }
            if (PH & 32) { OPAQUE_GRID(); (void)gw; (void)NGW; pg8::Sched<0> S; S.init(64, 6, QL, KWS(WS_CQ), nullptr, KWS(WS_WQUP), G, bx);
              pg8::EpiLatUp<true> E{BF(WS_R1), BF(WS_R4), (const float*)KWS(WS_SSQQ), (const float*)KWS(WS_COS), (const float*)KWS(WS_SIN)}; run_gemm(lds, QL, S, E); }
            GRID_SYNC();
            if (PH & 64) { OPAQUE_GRID(); (void)gw; (void)NGW; const bf16_t* R1 = BF(WS_R1); const bf16_t* R2 = BF(WS_R2); const bf16_t* R3 = BF(WS_R3); const bf16_t* R4 = BF(WS_R4); const bf16_t* KR = BF(WS_KR);
              for (int rep = 0; rep < REP_MLA; ++rep)
              for (int v0 = bx; v0 < 256; v0 += G) { const int vcu = (G == 256) ? (v0 % 8) * 32 + v0 / 8 : v0; const int bh = vcu >> 3, s = vcu & 7;
#pragma unroll 1
                for (int i = 0; i < 2; ++i) { const int qb = (i == 0) ? s : 15 - s;
                    att::attn_unit<96, false, 2>(lds, bh >> 4, bh & 15, qb * 512, R1, R4, R2, KR, R3, BF(WS_HN), nullptr); } } }
        }
        GRID_SYNC();
        if (PH & 128) { OPAQUE_GRID(); (void)gw; (void)NGW; pg8::Sched<0> S; S.init(64, 4, 1024, KWS(WS_HN), nullptr, KWS(l == 0 ? WS_WO : WS_BWO), G, bx);
          pg8::EpiRes E{l == 0 ? KIN(0) : (const float*)KOUT, KOUT, MODV + (size_t)l * 2 * 6144 + 2048}; run_gemm(lds, 1024, S, E); }
        GRID_SYNC();
        { OPAQUE_LANE(); OPAQUE_GRID(); (void)G; (void)bx; const float* out = KOUT; const float* modl = MODV + (size_t)l * 2 * 6144; bf16_t* HN = BF(WS_HN); const float* g = KIN(6) + l * DM;
          for (int m = gw; m < T; m += NGW) { const int b = m / SEQ, s = m % SEQ; f32x4 v[4]; const float rstd = row_rstd(out + (size_t)m * DM, lane, v);
            mod_store(v, rstd, g, modl + b * 6144 + 3072, modl + b * 6144 + 4096, HN + ((size_t)b * PADROWS + 2 + s) * DM, lane); }
          if (gw < 4) { bf16_t* z = HN + ((size_t)(gw >> 1) * PADROWS + (gw & 1)) * DM;
#pragma unroll
            for (int j = 0; j < 4; ++j) ((u32x2*)z)[64 * j + lane] = (u32x2){0u, 0u}; } }
        GRID_SYNC();
        if (PH & 256) { OPAQUE_GRID(); (void)gw; (void)NGW; pg8::Sched<1> S; S.init(2 * FT, 22, 1024, KWS(WS_HN), nullptr, KWS(WS_WIN + (size_t)l * FFN2 * 1024 * 2), G, bx);
          pg8::EpiConv E{KIN(24) + (size_t)l * 3 * FFN2, KIN(25) + (size_t)l * FFN2, BF(WS_ACT)};
          for (int rep = 0; rep < REP_FFNIN; ++rep) run_gemm(lds, 1024, S, E); }
        GRID_SYNC();
        if (PH & 512) { OPAQUE_GRID(); (void)gw; (void)NGW; pg8::Sched<0> S; S.init(64, 4, FFN, KWS(WS_ACT), nullptr, KWS(WS_WOUT + (size_t)l * 1024 * FFN * 2), G, bx);
          pg8::EpiRes E{KOUT, KOUT, MODV + (size_t)l * 2 * 6144 + 5120}; run_gemm(lds, FFN, S, E); }
        GRID_SYNC();
    }
    { OPAQUE_LANE(); OPAQUE_GRID(); (void)G; (void)bx; float* out = KOUT; const f32x4* fg = (const f32x4*)karg(27);
      for (int m = gw; m < T; m += NGW) { f32x4 v[4]; const float rstd = row_rstd(out + (size_t)m * DM, lane, v);
#pragma unroll
        for (int j = 0; j < 4; ++j) { const f32x4 gg = fg[64 * j + lane]; ((f32x4*)(out + (size_t)m * DM))[64 * j + lane] = v[j] * rstd * gg; } } }
}

extern "C" void kernel_launch(void* const* d_in, const int* in_sizes, int n_in, void* d_out, int out_size, void* d_ws, size_t ws_size, hipStream_t stream) {
    static int grid_blocks = 0;
    if (grid_blocks == 0) {
        if (n_in != 28 || out_size != T * DM || ws_size < WS_END) { fprintf(stderr, "kernel_launch: unexpected problem (n_in %d out %d ws %zu)\n", n_in, out_size, ws_size); grid_blocks = -1; return; }
        int dev = 0, cus = 0, per_cu = 0;
        hipGetDevice(&dev); hipDeviceGetAttribute(&cus, hipDeviceAttributeMultiprocessorCount, dev);
        if (hipFuncSetAttribute((const void*)fwd_megakernel, hipFuncAttributeMaxDynamicSharedMemorySize, LDS_BYTES) != hipSuccess) { fprintf(stderr, "kernel_launch: hipFuncSetAttribute failed\n"); grid_blocks = -1; return; }
        if (hipOccupancyMaxActiveBlocksPerMultiprocessor(&per_cu, (const void*)fwd_megakernel, 512, LDS_BYTES) != hipSuccess || per_cu < 1) { fprintf(stderr, "kernel_launch: occupancy query says %d\n", per_cu); per_cu = 1; (void)hipGetLastError(); }
        grid_blocks = cus * per_cu;
        if (grid_blocks > 256) grid_blocks = 256;
    }
    if (grid_blocks < 0) return;
    Params p{};
    for (int i = 0; i < 28; ++i) p.in[i] = d_in[i];
    p.out = (float*)d_out; p.ws = (unsigned char*)d_ws;
    void* args[] = {&p};
    hipError_t e = hipLaunchCooperativeKernel((const void*)fwd_megakernel, dim3(grid_blocks), dim3(512), args, LDS_BYTES, stream);
    if (e != hipSuccess) fprintf(stderr, "cooperative launch failed: %s (grid %d)\n", hipGetErrorString(e), grid_blocks);
}
```

```cpp
#include <hip/hip_runtime.h>
#include <hip/hip_cooperative_groups.h>
#include <cstdio>
#include <cstdint>
#ifndef REP_MLA
#define REP_MLA 1
#endif
#ifndef REP_ATTA
#define REP_ATTA 1
#endif
#ifndef REP_FFNIN
#define REP_FFNIN 1
#endif
#ifndef REP_QKV
#define REP_QKV 1
#endif
#ifndef REP_P0
#define REP_P0 1
#endif
#ifndef EXTRA_SYNCS
#define EXTRA_SYNCS 0
#endif
#ifndef REP_NORM1
#define REP_NORM1 1
#endif
#ifndef REP_FFNOUT_L0
#define REP_FFNOUT_L0 0
#endif
#ifndef PH
#define PH 0xFFFF
#endif
namespace cg = cooperative_groups;

#define LAS __attribute__((address_space(3)))
typedef unsigned short bf16_t;
typedef short bf16x8 __attribute__((ext_vector_type(8)));
typedef short s16x4 __attribute__((ext_vector_type(4)));
typedef float f32x2 __attribute__((ext_vector_type(2)));
typedef float f32x4 __attribute__((ext_vector_type(4)));
typedef float f32x16 __attribute__((ext_vector_type(16)));
typedef unsigned u32x2 __attribute__((ext_vector_type(2)));
typedef unsigned u32x4 __attribute__((ext_vector_type(4)));

constexpr int BATCH = 2, SEQ = 8192, DM = 1024, T = BATCH * SEQ, FFN = 2816, FFN2 = 5632;
constexpr int NH = 16, KVL = 256, QL = 384, ROPE = 32;
constexpr int PADROWS = 8448, FT = 33;
constexpr float EPS = 1e-6f;
constexpr float LOG2E = 1.4426950408889634f;
constexpr float QS_A = 0.125f * LOG2E;
constexpr float QS_B = 0.10206207261596577f * LOG2E;

constexpr size_t MiB = 1u << 20;
constexpr size_t WS_MODV = 0;
constexpr size_t WS_SSQKV = 256 * 1024;
constexpr size_t WS_SSQQ = 512 * 1024;
constexpr size_t WS_COS = 1 * MiB, WS_SIN = 2 * MiB;
constexpr size_t WS_BAR = 3 * MiB;
constexpr size_t WS_WQKV = 4 * MiB;
constexpr size_t WS_WO = 10 * MiB;
constexpr size_t WS_WIN = 12 * MiB;
constexpr size_t WS_WOUT = 34 * MiB;
constexpr size_t WS_WLD = 45 * MiB;
constexpr size_t WS_WKVUP = 47 * MiB;
constexpr size_t WS_WQUP = 48 * MiB;
constexpr size_t WS_BWO = 50 * MiB;
constexpr size_t WS_HN = 52 * MiB;
constexpr size_t WS_R1 = 86 * MiB;
constexpr size_t WS_R2 = 118 * MiB;
constexpr size_t WS_R3 = 150 * MiB;
constexpr size_t WS_R4 = 182 * MiB;
constexpr size_t WS_ACT = 86 * MiB;
constexpr size_t WS_HN1 = 198 * MiB;
constexpr size_t WS_CKV = 230 * MiB;
constexpr size_t WS_CQ = 238 * MiB;
constexpr size_t WS_KR = 250 * MiB;
constexpr size_t WS_END = 251 * MiB;

constexpr int RING_BYTES = 131072;
constexpr int XCH_OFF = RING_BYTES;
constexpr int MISC_OFF = XCH_OFF + 8192;
constexpr int LDS_BYTES = 147456;

__device__ __forceinline__ unsigned cvt_pk_bf16(float lo, float hi) { unsigned r; asm volatile("v_cvt_pk_bf16_f32 %0, %1, %2" : "=v"(r) : "v"(lo), "v"(hi)); return r; }
__device__ __forceinline__ float lane_read(float v, int src_lane) { return __builtin_bit_cast(float, __builtin_amdgcn_ds_bpermute(src_lane << 2, __builtin_bit_cast(int, v))); }
template <int N> __device__ __forceinline__ float dpp_ror(float x) { return __builtin_bit_cast(float, __builtin_amdgcn_update_dpp(0, __builtin_bit_cast(int, x), 0x120 + N, 0xf, 0xf, false)); }
template <int N> __device__ __forceinline__ float dpp_shr_keep(float old, float x) { return __builtin_bit_cast(float, __builtin_amdgcn_update_dpp(__builtin_bit_cast(int, old), __builtin_bit_cast(int, x), 0x110 + N, 0xf, 0xf, false)); }
__device__ __forceinline__ float wave_sum(float v, int lane) {
#pragma unroll
    for (int o = 1; o < 64; o <<= 1) v += lane_read(v, lane ^ o);
    return v;
}

namespace pg8 {
#define PG8_LAS __attribute__((address_space(3)))
constexpr int BM = 256, BK = 64, HALF = 128, HTB = HALF * BK * 2, STAGE_BYTES = 8 * HTB, NXCD = 8, WGM = 8;
__host__ __device__ __forceinline__ int lds_byte(int r, int c) { const int st = (r >> 4) * 2 + (c >> 5), rr = r & 15, cc = c & 31, ob = rr * 64 + cc * 2; return st * 1024 + (ob ^ (((ob >> 9) & 1) << 5)); }
__host__ __device__ __forceinline__ void stage_rc(int b, int& R, int& C) { const int st = b / 1024, sb = b % 1024, swz = sb ^ (((sb >> 9) & 1) << 5); R = (st >> 1) * 16 + swz / 64; C = (st & 1) * 32 + (swz % 64) / 2; }
__host__ __device__ __forceinline__ int perm32(int rho) { const int n = rho >> 4, i = rho & 15; return 8 * (i >> 2) + 4 * n + (i & 3); }
struct Unit { int pm, pn; };

template <int MODE> struct Sched {
    int nM, nN, nwg, G, c, K; const char* A0; const char* A1; const char* B;
    __device__ void init(int nM_, int nN_, int K_, const void* a0, const void* a1, const void* b, int G_, int c_) { nM = nM_; nN = nN_; nwg = nM * nN; K = K_; A0 = (const char*)a0; A1 = (const char*)a1; B = (const char*)b; G = G_; c = c_; }
    __device__ bool next(int i, Unit& u) const {
        const long L = (long)i * G + c; if (L >= nwg) return false;
        int wgid = (int)L; { const int q = nwg / NXCD, r = nwg % NXCD, xcd = wgid % NXCD, off = wgid / NXCD; wgid = (xcd < r ? xcd * (q + 1) : r * (q + 1) + (xcd - r) * q) + off; }
        const int nig = WGM * nN, gid = wgid / nig, fm = gid * WGM, gsz = (nM - fm) < WGM ? (nM - fm) : WGM;
        u.pm = fm + ((wgid % nig) % gsz); u.pn = (wgid % nig) / gsz; return true;
    }
    __device__ __forceinline__ const char* abase(const Unit& u) const {
        if (MODE == 1) { const int b = u.pm / FT, i = u.pm % FT; return A0 + ((size_t)b * PADROWS + (size_t)254 * i) * (size_t)K * 2; }
        if (MODE == 2) return (u.pn < 2 ? A0 : A1) + (size_t)u.pm * 256 * K * 2;
        return A0 + (size_t)u.pm * 256 * K * 2;
    }
    __device__ __forceinline__ const char* bbase(const Unit& u) const { return B + (size_t)u.pn * 256 * K * 2; }
};
typedef const f32x4 (&AccRef)[2][2][4][2];

struct EpiBf16 {
    static constexpr bool PERM = true;
    bf16_t* O; int ldc; int split_cols; size_t split_stride; float scale0;
    __device__ __forceinline__ void operator()(AccRef acc, const Unit& u, int wr, int wc, int fr_in, int fq_in, PG8_LAS unsigned char*) const {
        int fr = fr_in, fq = fq_in; asm volatile("" : "+v"(fr), "+v"(fq));
        const int row0 = u.pm * BM + wr * 64 + fr; int colt = u.pn * BM; bf16_t* base = O;
        float sc = 1.f; if (split_cols) { const int t = colt / split_cols; base += (size_t)t * split_stride; colt -= t * split_cols; if (t == 0) sc = scale0; }
        const int col0 = colt + wc * 32 + 8 * fq;
#pragma unroll
        for (int ai = 0; ai < 2; ++ai)
#pragma unroll
            for (int m = 0; m < 4; ++m) { bf16_t* rowp = base + (size_t)(row0 + ai * HALF + m * 16) * ldc + col0;
#pragma unroll
                for (int bj = 0; bj < 2; ++bj) { f32x4 v0 = acc[ai][bj][m][0] * sc, v1 = acc[ai][bj][m][1] * sc;
                    u32x4 w; w.x = cvt_pk_bf16(v0[0], v0[1]); w.y = cvt_pk_bf16(v0[2], v0[3]); w.z = cvt_pk_bf16(v1[0], v1[1]); w.w = cvt_pk_bf16(v1[2], v1[3]);
                    *(u32x4*)(rowp + bj * HALF) = w; } }
    }
};
struct EpiRes {
    static constexpr bool PERM = false;
    const float* hin; float* hout; const float* gate;
    __device__ __forceinline__ void operator()(AccRef acc, const Unit& u, int wr, int wc, int fr_in, int fq_in, PG8_LAS unsigned char*) const {
        int fr = fr_in, fq = fq_in; asm volatile("" : "+v"(fr), "+v"(fq));
        const int row0 = u.pm * BM + wr * 64 + fr, col0 = u.pn * BM + wc * 32 + 4 * fq, b = (u.pm * BM) / SEQ;
        const float* gp = gate + (size_t)b * 6144 + col0;
        f32x4 gv[2][2];
#pragma unroll
        for (int bj = 0; bj < 2; ++bj)
#pragma unroll
            for (int n = 0; n < 2; ++n) gv[bj][n] = *(const f32x4*)(gp + bj * HALF + n * 16);
#pragma unroll
        for (int ai = 0; ai < 2; ++ai)
#pragma unroll
            for (int m = 0; m < 4; ++m) { const size_t off = (size_t)(row0 + ai * HALF + m * 16) * DM + col0;
#pragma unroll
                for (int bj = 0; bj < 2; ++bj)
#pragma unroll
                    for (int n = 0; n < 2; ++n) { const f32x4 bs = *(const f32x4*)(hin + off + bj * HALF + n * 16);
                        *(f32x4*)(hout + off + bj * HALF + n * 16) = bs + gv[bj][n] * acc[ai][bj][m][n]; }
                if (m & 1) asm volatile("" ::: "memory"); }
    }
};
struct EpiConv {
    static constexpr bool PERM = true;
    const float* cw; const float* cb; bf16_t* act;
    __device__ __forceinline__ void operator()(AccRef acc, const Unit& u, int wr, int wc, int fr_in, int fq_in, PG8_LAS unsigned char* lds) const {
        int fr = fr_in, fq = fq_in; asm volatile("" : "+v"(fr), "+v"(fq));
        PG8_LAS f32x4* X = (PG8_LAS f32x4*)(lds + XCH_OFF);
        const int lane = fr + 16 * fq;
        if (fr >= 14) {
#pragma unroll
            for (int ai = 0; ai < 2; ++ai)
#pragma unroll
                for (int bj = 0; bj < 2; ++bj)
#pragma unroll
                    for (int n = 0; n < 2; ++n) X[((((((ai * 2 + wr) * 2 + (fr - 14)) * 4 + wc) * 2 + bj) * 2 + n) * 4) + fq] = acc[ai][bj][3][n];
        }
        asm volatile("s_waitcnt lgkmcnt(0)" ::: "memory"); __builtin_amdgcn_s_barrier(); asm volatile("" ::: "memory");
        const int b = u.pm / FT, it = u.pm % FT;
#pragma unroll
        for (int n = 0; n < 2; ++n) {
            const int gc = 128 * u.pn + 32 * wc + 8 * fq + 4 * n;
            const f32x4 wg0 = *(const f32x4*)(cw + gc), wg1 = *(const f32x4*)(cw + FFN2 + gc), wg2 = *(const f32x4*)(cw + 2 * FFN2 + gc), bg = *(const f32x4*)(cb + gc);
            const f32x4 wv0 = *(const f32x4*)(cw + FFN + gc), wv1 = *(const f32x4*)(cw + FFN2 + FFN + gc), wv2 = *(const f32x4*)(cw + 2 * FFN2 + FFN + gc), bv = *(const f32x4*)(cb + FFN + gc);
#pragma unroll
            for (int ai = 0; ai < 2; ++ai) {
                const int G = ai * 2 + wr;
                f32x4 pg = (f32x4){0.f, 0.f, 0.f, 0.f}, pv = pg;
                if (G > 0) {
                    const int rr = (fr == 15) ? 1 : 0;
                    pg = X[((((((G - 1) * 2 + rr) * 4 + wc) * 2 + 0) * 2 + n) * 4) + fq];
                    pv = X[((((((G - 1) * 2 + rr) * 4 + wc) * 2 + 1) * 2 + n) * 4) + fq];
                }
                float g_r1[4], g_r2[4], v_r1[4], v_r2[4];
#pragma unroll
                for (int e = 0; e < 4; ++e) { g_r1[e] = dpp_ror<1>(pg[e]); g_r2[e] = dpp_ror<2>(pg[e]); v_r1[e] = dpp_ror<1>(pv[e]); v_r2[e] = dpp_ror<2>(pv[e]); }
#pragma unroll
                for (int m = 0; m < 4; ++m) {
                    const f32x4 cg = acc[ai][0][m][n], cv = acc[ai][1][m][n];
                    float o[4];
#pragma unroll
                    for (int e = 0; e < 4; ++e) {
                        const float g1 = dpp_shr_keep<1>(g_r1[e], cg[e]), g2 = dpp_shr_keep<2>(g_r2[e], cg[e]);
                        const float v1 = dpp_shr_keep<1>(v_r1[e], cv[e]), v2 = dpp_shr_keep<2>(v_r2[e], cv[e]);
                        if (m < 3) { g_r1[e] = dpp_ror<1>(cg[e]); g_r2[e] = dpp_ror<2>(cg[e]); v_r1[e] = dpp_ror<1>(cv[e]); v_r2[e] = dpp_ror<2>(cv[e]); }
                        const float yg = bg[e] + wg0[e] * g2 + wg1[e] * g1 + wg2[e] * cg[e];
                        const float yv = bv[e] + wv0[e] * v2 + wv1[e] * v1 + wv2[e] * cv[e];
                        const float sg = yg * __builtin_amdgcn_rcpf(1.0f + __builtin_amdgcn_exp2f(-yg * LOG2E));
                        o[e] = sg * yv;
                    }
                    const int R = ai * HALF + wr * 64 + m * 16 + fr, tok = 254 * it - 2 + R;
                    if (R >= 2 && tok < SEQ) { u32x2 w; w.x = cvt_pk_bf16(o[0], o[1]); w.y = cvt_pk_bf16(o[2], o[3]);
                        *(u32x2*)(act + ((size_t)b * SEQ + tok) * FFN + gc) = w; }
                }
            }
        }
    }
};
struct EpiLatDown {
    static constexpr bool PERM = false;
    bf16_t* ckv; bf16_t* cq; bf16_t* kr; float* ssqkv; float* ssqq; const float* cosT; const float* sinT;
    __device__ __forceinline__ void operator()(AccRef acc, const Unit& u, int wr, int wc, int fr_in, int fq_in, PG8_LAS unsigned char*) const {
        int fr = fr_in, fq = fq_in; asm volatile("" : "+v"(fr), "+v"(fq));
        const int row0 = u.pm * BM + wr * 64 + fr, cl = wc * 32 + 4 * fq;
        if (u.pn == 1) {
            if (wc == 0) {
#pragma unroll
                for (int ai = 0; ai < 2; ++ai)
#pragma unroll
                    for (int m = 0; m < 4; ++m) { const int row = row0 + ai * HALF + m * 16;
                        const f32x4 c = *(const f32x4*)(cosT + (size_t)row * 16 + 4 * fq), s = *(const f32x4*)(sinT + (size_t)row * 16 + 4 * fq);
                        const f32x4 t1 = acc[ai][0][m][0], t2 = acc[ai][0][m][1];
                        const f32x4 o1 = t1 * c - t2 * s, o2 = t2 * c + t1 * s;
                        u32x2 w1, w2; w1.x = cvt_pk_bf16(o1[0], o1[1]); w1.y = cvt_pk_bf16(o1[2], o1[3]); w2.x = cvt_pk_bf16(o2[0], o2[1]); w2.y = cvt_pk_bf16(o2[2], o2[3]);
                        *(u32x2*)(kr + (size_t)row * ROPE + 4 * fq) = w1; *(u32x2*)(kr + (size_t)row * ROPE + 16 + 4 * fq) = w2; }
            }
            return;
        }
        const bool isq = u.pn >= 2; const int cbase = isq ? (u.pn - 2) * 256 : 0, ld = isq ? QL : KVL; bf16_t* O = isq ? cq : ckv;
#pragma unroll
        for (int ai = 0; ai < 2; ++ai)
#pragma unroll
            for (int m = 0; m < 4; ++m) { const int row = row0 + ai * HALF + m * 16; float ss = 0.f;
#pragma unroll
                for (int bj = 0; bj < 2; ++bj)
#pragma unroll
                    for (int n = 0; n < 2; ++n) { const f32x4 v = acc[ai][bj][m][n]; ss += (v[0] * v[0] + v[1] * v[1]) + (v[2] * v[2] + v[3] * v[3]);
                        const int c = cbase + bj * HALF + cl + n * 16;
                        if (c < ld) { u32x2 w; w.x = cvt_pk_bf16(v[0], v[1]); w.y = cvt_pk_bf16(v[2], v[3]); *(u32x2*)(O + (size_t)row * ld + c) = w; } }
                ss += lane_read(ss, (fr + 16 * fq) ^ 16); ss += lane_read(ss, (fr + 16 * fq) ^ 32);
                if (fq == 0) { if (isq) ssqq[(size_t)row * 8 + (u.pn - 2) * 4 + wc] = ss; else ssqkv[(size_t)row * 4 + wc] = ss; } }
    }
};
template <bool ISQ> struct EpiLatUp {
    static constexpr bool PERM = false;
    bf16_t* O0; bf16_t* O1; const float* ssq; const float* cosT; const float* sinT;
    __device__ __forceinline__ void operator()(AccRef acc, const Unit& u, int wr, int wc, int fr_in, int fq_in, PG8_LAS unsigned char*) const {
        int fr = fr_in, fq = fq_in; asm volatile("" : "+v"(fr), "+v"(fq));
        const int row0 = u.pm * BM + wr * 64 + fr, cl = wc * 32 + 4 * fq;
        const bool second = u.pn >= 4; const int ct = (second ? u.pn - 4 : u.pn) * 256; bf16_t* O = second ? O1 : O0; constexpr int ld = DM;
#pragma unroll
        for (int ai = 0; ai < 2; ++ai)
#pragma unroll
            for (int m = 0; m < 4; ++m) { const int row = row0 + ai * HALF + m * 16; float rs;
                if (ISQ) { const f32x4 a = *(const f32x4*)(ssq + (size_t)row * 8), b2 = *(const f32x4*)(ssq + (size_t)row * 8 + 4);
                    rs = __builtin_amdgcn_rsqf((((a[0] + a[1]) + (a[2] + a[3])) + ((b2[0] + b2[1]) + (b2[2] + b2[3]))) * (1.0f / QL) + EPS) * QS_B; }
                else { const f32x4 a = *(const f32x4*)(ssq + (size_t)row * 4); rs = __builtin_amdgcn_rsqf(((a[0] + a[1]) + (a[2] + a[3])) * (1.0f / KVL) + EPS); }
                asm volatile("" : "+v"(rs) :: "memory");
                if (ISQ && second) {
                    const f32x4 c = *(const f32x4*)(cosT + (size_t)row * 16 + 4 * fq), s = *(const f32x4*)(sinT + (size_t)row * 16 + 4 * fq);
#pragma unroll
                    for (int bj = 0; bj < 2; ++bj) { const f32x4 t1 = acc[ai][bj][m][0] * rs, t2 = acc[ai][bj][m][1] * rs;
                        const f32x4 o1 = t1 * c - t2 * s, o2 = t2 * c + t1 * s;
                        u32x2 w1, w2; w1.x = cvt_pk_bf16(o1[0], o1[1]); w1.y = cvt_pk_bf16(o1[2], o1[3]); w2.x = cvt_pk_bf16(o2[0], o2[1]); w2.y = cvt_pk_bf16(o2[2], o2[3]);
                        bf16_t* p = O + (size_t)row * ld + ct + bj * HALF + cl; *(u32x2*)p = w1; *(u32x2*)(p + 16) = w2; asm volatile("" ::: "memory"); }
                } else {
#pragma unroll
                    for (int bj = 0; bj < 2; ++bj)
#pragma unroll
                        for (int n = 0; n < 2; ++n) { const f32x4 v = acc[ai][bj][m][n] * rs; u32x2 w; w.x = cvt_pk_bf16(v[0], v[1]); w.y = cvt_pk_bf16(v[2], v[3]);
                            *(u32x2*)(O + (size_t)row * ld + ct + bj * HALF + cl + n * 16) = w; }
                }
                asm volatile("" ::: "memory"); }
    }
};
template <class Epi, class Sched, bool ALIGN_EPI = false, bool SP2 = false>
__device__ __forceinline__ void gemm_phase(PG8_LAS unsigned char* lds, const int K, const Sched& S, const Epi& E) {
    int tid_ = threadIdx.x; asm volatile("" : "+v"(tid_));
    const int tid = tid_, wid = __builtin_amdgcn_readfirstlane(tid >> 6), lane = tid & 63, wr = wid >> 2, wc = wid & 3, fr = lane & 15, fq = lane >> 4;
    const int nt = K / BK;
    unsigned voffA[2], voffB[2];
#pragma unroll
    for (int i = 0; i < 2; ++i) { int R, C; stage_rc(tid * 16 + i * 8192, R, C); const int Rb = Epi::PERM ? ((R & ~31) + perm32(R & 31)) : R;
        voffA[i] = (unsigned)(R * K + C) * 2u; voffB[i] = (unsigned)(Rb * K + C) * 2u; }
    const size_t kstep = (size_t)(BK * 2);
    const size_t hstep = (size_t)HALF * K * 2;
    const unsigned ldsw = (unsigned)wid * 1024u;
    const int aoff = lds_byte(wr * 64 + fr, fq * 8), boff = lds_byte(wc * 32 + fr, fq * 8);
#define PG8_SA(b, h) (((b) * 2 + (h)) * HTB)
#define PG8_SB(b, h) ((4 + (b) * 2 + (h)) * HTB)
#define PG8_STAGE(bufoff, gbase, voff) do { _Pragma("unroll") for (int _i = 0; _i < 2; ++_i) \
        __builtin_amdgcn_global_load_lds((const unsigned*)((const char*)(gbase) + (voff)[_i]), (PG8_LAS unsigned*)(lds + (bufoff) + ldsw + _i * 8192), 16, 0, 0); } while (0)
#define PG8_LDA(dst, b, h) do { _Pragma("unroll") for (int m = 0; m < 4; ++m) _Pragma("unroll") for (int k = 0; k < 2; ++k) dst[m][k] = *(const PG8_LAS bf16x8*)(lds + PG8_SA(b, h) + aoff + m * 2048 + k * 1024); } while (0)
#define PG8_LDB(dst, b, h) do { _Pragma("unroll") for (int n = 0; n < 2; ++n) _Pragma("unroll") for (int k = 0; k < 2; ++k) dst[n][k] = *(const PG8_LAS bf16x8*)(lds + PG8_SB(b, h) + boff + n * 2048 + k * 1024); } while (0)
#define PG8_MMA(ai, bj, At, Bt) do { __builtin_amdgcn_s_setprio(1); _Pragma("unroll") for (int m = 0; m < 4; ++m) _Pragma("unroll") for (int n = 0; n < 2; ++n) _Pragma("unroll") for (int k = 0; k < 2; ++k) \
        acc[ai][bj][m][n] = __builtin_amdgcn_mfma_f32_16x16x32_bf16(Bt[n][k], At[m][k], acc[ai][bj][m][n], 0, 0, 0); __builtin_amdgcn_s_setprio(0); } while (0)
#define PG8_WAIT_V(n) asm volatile("s_waitcnt vmcnt(" #n ")" ::: "memory")
#define PG8_WAIT_L(n) asm volatile("s_waitcnt lgkmcnt(" #n ")" ::: "memory")
#define PG8_BAR __builtin_amdgcn_s_barrier()
#define PG8_SCHED __builtin_amdgcn_sched_barrier(0)
    Unit cur, nxt; int ui = 0;
    if (!S.next(0, cur)) return;
    f32x4 acc[2][2][4][2];
#pragma unroll
    for (int a = 0; a < 2; ++a)
#pragma unroll
        for (int b = 0; b < 2; ++b)
#pragma unroll
            for (int m = 0; m < 4; ++m)
#pragma unroll
                for (int n = 0; n < 2; ++n) acc[a][b][m][n] = (f32x4){0.f, 0.f, 0.f, 0.f};
    bf16x8 At[4][2], B0[2][2], B1[2][2];
    const char* cA = S.abase(cur); const char* cB = S.bbase(cur);
    if constexpr (SP2) {
        PG8_STAGE(PG8_SB(0, 0), cB, voffB); PG8_STAGE(PG8_SB(0, 1), cB + hstep, voffB); PG8_STAGE(PG8_SA(0, 0), cA, voffA); PG8_STAGE(PG8_SA(0, 1), cA + hstep, voffA);
        if (wr == 1) PG8_BAR;
        PG8_WAIT_V(2); PG8_BAR;
        PG8_STAGE(PG8_SB(1, 0), cB + kstep, voffB); PG8_STAGE(PG8_SA(1, 0), cA + kstep, voffA); PG8_STAGE(PG8_SB(1, 1), cB + hstep + kstep, voffB);
        PG8_WAIT_V(6); PG8_BAR;
    } else {
        PG8_STAGE(PG8_SB(0, 0), cB, voffB); PG8_STAGE(PG8_SA(0, 0), cA, voffA); PG8_STAGE(PG8_SB(0, 1), cB + hstep, voffB); PG8_STAGE(PG8_SA(0, 1), cA + hstep, voffA);
        if (wr == 1) PG8_BAR;
        PG8_WAIT_V(4); PG8_BAR;
        PG8_STAGE(PG8_SB(1, 0), cB + kstep, voffB); PG8_STAGE(PG8_SA(1, 0), cA + kstep, voffA); PG8_STAGE(PG8_SB(1, 1), cB + hstep + kstep, voffB);
        PG8_WAIT_V(6); PG8_BAR;
    }
    for (;;) {
        const bool has_next = S.next(ui + 1, nxt);
        const char* nA = has_next ? S.abase(nxt) : cA; const char* nB = has_next ? S.bbase(nxt) : cB;
        for (int t = 0; t < nt; t += 2) {
            const bool last = (t == nt - 2);
            const char* a1 = cA + (size_t)(t + 1) * kstep;
            const char* a2 = last ? nA : cA + (size_t)(t + 2) * kstep; const char* b2 = last ? nB : cB + (size_t)(t + 2) * kstep;
            const char* a3 = a2 + kstep; const char* b3 = b2 + kstep;
            if constexpr (SP2) {
            PG8_LDB(B0, 0, 0); PG8_LDB(B1, 0, 1); PG8_SCHED; PG8_LDA(At, 0, 0); PG8_STAGE(PG8_SA(1, 1), a1 + hstep, voffA);
            PG8_WAIT_V(8); PG8_WAIT_L(0); PG8_BAR; PG8_MMA(0, 0, At, B0); PG8_MMA(0, 1, At, B1); PG8_BAR; PG8_SCHED;
            PG8_LDA(At, 0, 1); PG8_STAGE(PG8_SB(0, 0), b2, voffB); PG8_STAGE(PG8_SB(0, 1), b2 + hstep, voffB); PG8_STAGE(PG8_SA(0, 0), a2, voffA);
            PG8_WAIT_V(8); PG8_WAIT_L(0); PG8_BAR; PG8_MMA(1, 0, At, B0); PG8_MMA(1, 1, At, B1); PG8_BAR; PG8_SCHED;
            PG8_LDB(B0, 1, 0); PG8_LDB(B1, 1, 1); PG8_SCHED; PG8_LDA(At, 1, 0); PG8_STAGE(PG8_SA(0, 1), a2 + hstep, voffA);
            PG8_WAIT_V(8); PG8_WAIT_L(0); PG8_BAR; PG8_MMA(0, 0, At, B0); PG8_MMA(0, 1, At, B1); PG8_BAR; PG8_SCHED;
            PG8_LDA(At, 1, 1); PG8_STAGE(PG8_SB(1, 0), b3, voffB); PG8_STAGE(PG8_SB(1, 1), b3 + hstep, voffB); PG8_STAGE(PG8_SA(1, 0), a3, voffA);
            PG8_WAIT_V(8); PG8_WAIT_L(0); PG8_BAR; PG8_MMA(1, 0, At, B0); PG8_MMA(1, 1, At, B1); PG8_BAR; PG8_SCHED;
            } else {
            PG8_LDB(B0, 0, 0); PG8_SCHED; PG8_LDA(At, 0, 0); PG8_STAGE(PG8_SA(1, 1), a1 + hstep, voffA);
            PG8_WAIT_L(8); PG8_BAR; PG8_WAIT_L(0); PG8_MMA(0, 0, At, B0); PG8_BAR; PG8_SCHED;
            PG8_LDB(B1, 0, 1); PG8_STAGE(PG8_SB(0, 0), b2, voffB);
            PG8_BAR; PG8_WAIT_L(0); PG8_MMA(0, 1, At, B1); PG8_BAR;
            PG8_LDA(At, 0, 1); PG8_STAGE(PG8_SA(0, 0), a2, voffA);
            PG8_BAR; PG8_WAIT_L(0); PG8_MMA(1, 0, At, B0); PG8_BAR; PG8_SCHED;
            PG8_STAGE(PG8_SB(0, 1), b2 + hstep, voffB);
            PG8_WAIT_V(6); PG8_BAR; PG8_MMA(1, 1, At, B1); PG8_BAR;
            PG8_LDB(B0, 1, 0); PG8_SCHED; PG8_LDA(At, 1, 0); PG8_STAGE(PG8_SA(0, 1), a2 + hstep, voffA);
            PG8_WAIT_L(8); PG8_BAR; PG8_WAIT_L(0); PG8_MMA(0, 0, At, B0); PG8_BAR; PG8_SCHED;
            PG8_LDB(B1, 1, 1); PG8_STAGE(PG8_SB(1, 0), b3, voffB);
            PG8_BAR; PG8_WAIT_L(0); PG8_MMA(0, 1, At, B1); PG8_BAR;
            PG8_LDA(At, 1, 1); PG8_STAGE(PG8_SA(1, 0), a3, voffA);
            PG8_BAR; PG8_WAIT_L(0); PG8_MMA(1, 0, At, B0); PG8_BAR; PG8_SCHED;
            PG8_STAGE(PG8_SB(1, 1), b3 + hstep, voffB);
            PG8_WAIT_V(6); PG8_BAR; PG8_MMA(1, 1, At, B1); PG8_BAR;
            }
        }
        if constexpr (ALIGN_EPI) { if (wr == 0) PG8_BAR; }
        E(acc, cur, wr, wc, fr, fq, lds);
        if (!has_next) break;
#pragma unroll
        for (int a = 0; a < 2; ++a)
#pragma unroll
            for (int b = 0; b < 2; ++b)
#pragma unroll
                for (int m = 0; m < 4; ++m)
#pragma unroll
                    for (int n = 0; n < 2; ++n) acc[a][b][m][n] = (f32x4){0.f, 0.f, 0.f, 0.f};
        cur = nxt; cA = nA; cB = nB; ++ui;
        if constexpr (ALIGN_EPI) { if (wr == 1) PG8_BAR; }
    }
    PG8_WAIT_V(0);
    if constexpr (!ALIGN_EPI) { if (wr == 0) PG8_BAR; }
    PG8_BAR;
#undef PG8_SA
#undef PG8_SB
#undef PG8_STAGE
#undef PG8_LDA
#undef PG8_LDB
#undef PG8_MMA
#undef PG8_WAIT_V
#undef PG8_WAIT_L
#undef PG8_BAR
#undef PG8_SCHED
}
}
namespace att {
__device__ __forceinline__ int crow(int r, int hi) { return (r & 3) + 8 * (r >> 2) + 4 * hi; }
typedef short v4i16_t __attribute__((ext_vector_type(4)));
__device__ __forceinline__ s16x4 vtr(const LAS unsigned char* p) { return __builtin_bit_cast(s16x4, __builtin_amdgcn_ds_read_tr16_b64_v4i16((LAS v4i16_t*)p)); }
#define MFMA32(a, b, c) __builtin_amdgcn_mfma_f32_32x32x16_bf16((a), (b), (c), 0, 0, 0)

template <int DQK, bool BIAS, int NB>
__device__ __forceinline__ void attn_unit(LAS unsigned char* lds, int b, int h, int q0, const bf16_t* Qn, const bf16_t* Qr, const bf16_t* Kn, const bf16_t* Kr,
                                          const bf16_t* Vg, bf16_t* Og, const float* biasg) {
    constexpr int NC = DQK / 8, KSZ = NC * 1024, ND = DQK / 16;
    constexpr int OFF_V = 2 * KSZ, OFF_WSF = OFF_V + 16384, OFF_BT = OFF_WSF + 8 * 64 * NB * 4;
    int tid_ = threadIdx.x; asm volatile("" : "+v"(tid_));
    const int tid = tid_, lane = tid & 63, r32 = lane & 31, hi = lane >> 5; const int wid = __builtin_amdgcn_readfirstlane(tid >> 6);
    const size_t rowbase = (size_t)b * SEQ;
    const int qw = q0 + wid * 32 * NB;
    const int cwv = qw >> 6, c0 = q0 >> 6;
    const int tlo = BIAS ? (c0 - 8 > 0 ? c0 - 8 : 0) : 0, thi = c0 + 4 * NB;
    const int wlo = BIAS ? (cwv - 8 > 0 ? cwv - 8 : 0) : 0, whi = cwv;
    LAS float* wsf = (LAS float*)(lds + OFF_WSF) + wid * 64 * NB;
    LAS float* bt = (LAS float*)(lds + OFF_BT);
    bf16x8 qf[NB][ND];
#pragma unroll
    for (int nb = 0; nb < NB; ++nb) {
        const size_t qrow = rowbase + qw + nb * 32 + r32;
#pragma unroll
        for (int d0 = 0; d0 < 4; ++d0) qf[nb][d0] = *(const bf16x8*)(Qn + qrow * DM + h * 64 + d0 * 16 + hi * 8);
        if constexpr (DQK == 96) {
#pragma unroll
            for (int d0 = 4; d0 < 6; ++d0) qf[nb][d0] = *(const bf16x8*)(Qr + qrow * DM + h * 32 + (d0 - 4) * 16 + hi * 8);
        }
    }
    if constexpr (BIAS) { for (int i = tid; i < 257; i += 512) bt[i] = biasg[i] * LOG2E; }
    const int ka_key = tid / NC, ka_c = tid % NC, kb_key = (tid + 512) / NC, kb_c = (tid + 512) % NC, v_key = tid >> 3, v_c = tid & 7;
    const bool has_kb = (DQK == 96) && (tid < 256);
    const int ka_dst = ka_c * 1024 + ka_key * 16, kb_dst = kb_c * 1024 + kb_key * 16;
    const int v_dst = (v_c >> 2) * 4096 + (v_key >> 4) * 1024 + (v_key & 15) * 64 + (v_c & 3) * 16;
    const bf16_t* pa_src = (ka_c < 8) ? Kn + (rowbase + ka_key) * DM + h * 64 + ka_c * 8 : Kr + (rowbase + ka_key) * ROPE + (ka_c - 8) * 8;
    const bf16_t* pb_src = (kb_c < 8) ? Kn + (rowbase + kb_key) * DM + h * 64 + kb_c * 8 : Kr + (rowbase + kb_key) * ROPE + (kb_c - 8) * 8;
    const int pa_step = (ka_c < 8) ? 64 * DM : 64 * ROPE, pb_step = (kb_c < 8) ? 64 * DM : 64 * ROPE;
    const bf16_t* pv_src = Vg + (rowbase + v_key) * DM + h * 64 + v_c * 8;
    u32x4 ra, rb, rv;
#define ATT_LOAD(t) do { ra = *(const u32x4*)(pa_src + (size_t)(t) * pa_step); if (has_kb) rb = *(const u32x4*)(pb_src + (size_t)(t) * pb_step); rv = *(const u32x4*)(pv_src + (size_t)(t) * 64 * DM); } while (0)
#define ATT_STORE(buf) do { *(LAS u32x4*)(lds + (buf) * KSZ + ka_dst) = ra; if (has_kb) *(LAS u32x4*)(lds + (buf) * KSZ + kb_dst) = rb; \
        *(LAS u32x4*)(lds + OFF_V + (buf) * 8192 + v_dst) = rv; } while (0)
    rb = (u32x4){0u, 0u, 0u, 0u};
    ATT_LOAD(tlo); ATT_STORE(0);
    __syncthreads();
    float mrun[NB], lrun[NB]; f32x16 o0[NB], o1[NB];
#pragma unroll
    for (int nb = 0; nb < NB; ++nb) { mrun[nb] = 0.f; lrun[nb] = 0.f; o0[nb] = (f32x16){}; o1[nb] = (f32x16){}; }
    const int vrd = (4 * hi + ((lane & 15) >> 2)) * 64 + ((lane >> 4) & 1) * 32 + (lane & 3) * 8;
    for (int t = tlo; t < thi; ++t) {
        const int cur = (t - tlo) & 1;
        const bool more = (t + 1 < thi);
        if (more) ATT_LOAD(t + 1);
        if (t >= wlo && t <= whi) {
            const LAS unsigned char* Kb = lds + cur * KSZ + hi * 1024 + r32 * 16;
            const LAS unsigned char* Vb = lds + OFF_V + cur * 8192 + vrd;
            f32x16 p0[NB], p1[NB];
#pragma unroll
            for (int nb = 0; nb < NB; ++nb) { p0[nb] = (f32x16){}; p1[nb] = (f32x16){}; }
            {
                bf16x8 k0 = *(const LAS bf16x8*)(Kb), k1 = *(const LAS bf16x8*)(Kb + 512);
#pragma unroll
                for (int d0 = 0; d0 < ND; ++d0) {
                    bf16x8 n0 = k0, n1 = k1;
                    if (d0 + 1 < ND) { n0 = *(const LAS bf16x8*)(Kb + (d0 + 1) * 2048); n1 = *(const LAS bf16x8*)(Kb + (d0 + 1) * 2048 + 512); }
                    __builtin_amdgcn_sched_barrier(0);
#pragma unroll
                    for (int nb = 0; nb < NB; ++nb) { p0[nb] = MFMA32(k0, qf[nb][d0], p0[nb]); p1[nb] = MFMA32(k1, qf[nb][d0], p1[nb]); }
                    __builtin_amdgcn_sched_barrier(0);
                    k0 = n0; k1 = n1;
                }
            }
            u32x4 pw[NB][4];
#pragma unroll
            for (int nb = 0; nb < NB; ++nb) {
                if constexpr (BIAS) {
                    const int dbase = qw + nb * 32 - t * 64;
                    if (dbase - 63 >= 128) { const float cb = bt[256];
#pragma unroll
                        for (int i = 0; i < 16; ++i) { p0[nb][i] += cb; p1[nb][i] += cb; } }
                    else {
#pragma unroll
                        for (int i = 0; i < 16; ++i) { const int d = dbase + r32 - crow(i, hi); const int i0 = (d < 128 ? d : 128) + 128, i1 = (d - 32 < 128 ? d - 32 : 128) + 128;
                            p0[nb][i] += bt[i0]; p1[nb][i] += bt[i1]; }
                    }
                }
                float ra_ = fmaxf(fmaxf(p0[nb][0], p1[nb][0]), p0[nb][1]), rb_ = fmaxf(fmaxf(p1[nb][1], p0[nb][2]), p1[nb][2]);
#pragma unroll
                for (int i = 3; i < 15; i += 2) { ra_ = fmaxf(fmaxf(ra_, p0[nb][i]), p1[nb][i]); rb_ = fmaxf(fmaxf(rb_, p0[nb][i + 1]), p1[nb][i + 1]); }
                float rm = fmaxf(fmaxf(ra_, rb_), fmaxf(p0[nb][15], p1[nb][15]));
                rm = fmaxf(rm, lane_read(rm, lane ^ 32));
                if (t == wlo) { mrun[nb] = rm; }
                else if (__any(rm > mrun[nb] + 8.0f)) {
                    const float dl = fmaxf(rm - mrun[nb], 0.f); const float al = __builtin_amdgcn_exp2f(-dl); mrun[nb] += dl; lrun[nb] *= al;
                    if (hi == 0) wsf[nb * 64 + r32] = al;
#pragma unroll
                    for (int i = 0; i < 16; ++i) { const float a = wsf[nb * 64 + crow(i, hi)]; o0[nb][i] *= a; o1[nb][i] *= a; }
                }
                float ls0 = 0.f, ls1 = 0.f; const float mm = mrun[nb];
#pragma unroll
                for (int i = 0; i < 16; ++i) { p0[nb][i] = __builtin_amdgcn_exp2f(p0[nb][i] - mm); p1[nb][i] = __builtin_amdgcn_exp2f(p1[nb][i] - mm); ls0 += p0[nb][i]; ls1 += p1[nb][i]; }
                lrun[nb] += ls0 + ls1;
#pragma unroll
                for (int k = 0; k < 4; ++k) { pw[nb][0][k] = cvt_pk_bf16(p0[nb][2 * k], p0[nb][2 * k + 1]); pw[nb][1][k] = cvt_pk_bf16(p0[nb][8 + 2 * k], p0[nb][8 + 2 * k + 1]);
                    pw[nb][2][k] = cvt_pk_bf16(p1[nb][2 * k], p1[nb][2 * k + 1]); pw[nb][3][k] = cvt_pk_bf16(p1[nb][8 + 2 * k], p1[nb][8 + 2 * k + 1]); }
            }
            {
                s16x4 a0 = vtr(Vb), a1 = vtr(Vb + 512), c0_ = vtr(Vb + 4096), c1_ = vtr(Vb + 4096 + 512);
#pragma unroll
                for (int ks = 0; ks < 4; ++ks) {
                    const bf16x8 v0 = (bf16x8){a0[0], a0[1], a0[2], a0[3], a1[0], a1[1], a1[2], a1[3]}, v1 = (bf16x8){c0_[0], c0_[1], c0_[2], c0_[3], c1_[0], c1_[1], c1_[2], c1_[3]};
                    if (ks + 1 < 4) { a0 = vtr(Vb + (ks + 1) * 1024); a1 = vtr(Vb + (ks + 1) * 1024 + 512); c0_ = vtr(Vb + 4096 + (ks + 1) * 1024); c1_ = vtr(Vb + 4096 + (ks + 1) * 1024 + 512); }
                    __builtin_amdgcn_sched_barrier(0);
#pragma unroll
                    for (int nb = 0; nb < NB; ++nb) { const bf16x8 pa = __builtin_bit_cast(bf16x8, pw[nb][ks]); o0[nb] = MFMA32(pa, v0, o0[nb]); o1[nb] = MFMA32(pa, v1, o1[nb]); }
                    __builtin_amdgcn_sched_barrier(0);
                }
            }
        }
        if (more) ATT_STORE(cur ^ 1);
        __syncthreads();
    }
#undef ATT_LOAD
#undef ATT_STORE
#pragma unroll
    for (int nb = 0; nb < NB; ++nb) {
        float lt = lrun[nb]; lt += lane_read(lt, lane ^ 32);
        if (hi == 0) wsf[nb * 64 + 32 + r32] = lt;
        bf16_t* Ow = Og + (rowbase + qw + nb * 32) * DM + h * 64 + r32;
#pragma unroll
        for (int i = 0; i < 16; ++i) { const int q = crow(i, hi); const float rl = __builtin_amdgcn_rcpf(wsf[nb * 64 + 32 + q]);
            const unsigned w0 = cvt_pk_bf16(o0[nb][i] * rl, 0.f), w1 = cvt_pk_bf16(o1[nb][i] * rl, 0.f);
            Ow[(size_t)q * DM] = (bf16_t)(w0 & 0xffffu); Ow[(size_t)q * DM + 32] = (bf16_t)(w1 & 0xffffu); }
    }
    __syncthreads();
}
#undef MFMA32
}
__device__ const float INV_FREQ[16] = {1.000000000e+00f, 5.623413324e-01f, 3.162277639e-01f, 1.778279394e-01f, 1.000000015e-01f, 5.623413250e-02f, 3.162277490e-02f, 1.778279431e-02f,
                                       9.999999776e-03f, 5.623413250e-03f, 3.162277630e-03f, 1.778279431e-03f, 1.000000047e-03f, 5.623413017e-04f, 3.162277571e-04f, 1.778279402e-04f};
__device__ __forceinline__ unsigned f2bf(float f) { unsigned u = __builtin_bit_cast(unsigned, f); return (u + 0x7fffu + ((u >> 16) & 1u)) >> 16; }
__device__ __forceinline__ unsigned pk2(float lo, float hi) { return f2bf(lo) | (f2bf(hi) << 16); }

struct Params { const void* in[28]; float* out; unsigned char* ws; };
__device__ __forceinline__ const void* karg(int i) { int z = 0; asm volatile("" : "+s"(z)); const void* const* kp = (const void* const*)__builtin_amdgcn_kernarg_segment_ptr(); return kp[i + z]; }
#define KIN(i) ((const float*)karg(i))
#define KOUT ((float*)karg(28))
#define KWS(off) ((unsigned char*)karg(29) + (off))

__device__ __forceinline__ void transpose_item(const float* W, int K, int N, bf16_t* WT, int mode, int row_off, const float* kscale, LAS float* scr, int item, int lane) {
    const int nblk = N / 32, kb = item / nblk, nb = item % nblk, k0 = 64 * kb, n0 = 32 * nb;
#pragma unroll 8
    for (int i = 0; i < 32; ++i) { const int kk = 2 * i + (lane >> 5); float v = W[(size_t)(k0 + kk) * N + n0 + (lane & 31)]; if (kscale) v *= kscale[k0 + kk]; scr[kk * 33 + (lane & 31)] = v; }
    asm volatile("s_waitcnt lgkmcnt(0)" ::: "memory");
    const int c = lane & 7;
#pragma unroll
    for (int j = 0; j < 4; ++j) { const int n = (lane >> 3) + 8 * j; const LAS float* s = scr + (8 * c) * 33 + n;
        u32x4 o; o.x = pk2(s[0 * 33], s[1 * 33]); o.y = pk2(s[2 * 33], s[3 * 33]); o.z = pk2(s[4 * 33], s[5 * 33]); o.w = pk2(s[6 * 33], s[7 * 33]);
        const int nn = n0 + n; int drow;
        if (mode == 0) drow = row_off + nn; else { const int jj = nn < FFN ? nn : nn - FFN; drow = 256 * (jj >> 7) + (nn < FFN ? 0 : 128) + (jj & 127); }
        *(u32x4*)(WT + (size_t)drow * K + k0 + 8 * c) = o; }
    asm volatile("s_waitcnt lgkmcnt(0)" ::: "memory");
}

__device__ __forceinline__ void p0_prologue(LAS unsigned char* lds, int G, int bx) {
    int tid_ = threadIdx.x; asm volatile("" : "+v"(tid_));
    const int tid = tid_, lane = tid & 63; const int wid = __builtin_amdgcn_readfirstlane(tid >> 6);
    unsigned char* ws = KWS(0);
    float* modv = (float*)(ws + WS_MODV);
    {
        LAS float* ca = (LAS float*)lds; LAS float* red = ca + 2048;
        const float* c = KIN(1);
        for (int i = tid; i < 2048; i += 512) { const float v = c[i]; ca[i] = v / (1.0f + __expf(-v)); }
        __syncthreads();
        for (int item = bx; item < 224; item += G) {
            const int col = item * 64; const float* W; const float* bias; float* out; int N, ostride;
            if (col < 12288) { const int l = col / 6144, cc = col % 6144; W = KIN(3) + (size_t)l * 1024 * 6144 + cc; N = 6144; bias = KIN(4) + l * 6144 + cc; out = modv + (size_t)l * 2 * 6144 + cc; ostride = 6144; }
            else { const int cc = col - 12288; W = KIN(10) + cc; N = 2048; bias = KIN(11) + cc; out = modv + 24576 + cc; ostride = 2048; }
            float a0 = 0.f, a1 = 0.f; const int kb = wid * 128;
#pragma unroll 16
            for (int k = 0; k < 128; ++k) { const float w = W[(size_t)(kb + k) * N + lane]; a0 += ca[kb + k] * w; a1 += ca[1024 + kb + k] * w; }
            red[(wid * 2 + 0) * 64 + lane] = a0; red[(wid * 2 + 1) * 64 + lane] = a1;
            __syncthreads();
            if (tid < 128) { const int bb = tid >> 6, ln = tid & 63; float s = 0.f;
#pragma unroll
                for (int w = 0; w < 8; ++w) s += red[(w * 2 + bb) * 64 + ln];
                out[(size_t)bb * ostride + ln] = s + bias[ln]; }
            __syncthreads();
        }
    }
    __syncthreads();
    {
        LAS float* scr = (LAS float*)(lds + wid * 16384);
        const int gw = bx * 8 + wid, NGW = G * 8;
        bf16_t* WQKV = (bf16_t*)(ws + WS_WQKV); bf16_t* WO = (bf16_t*)(ws + WS_WO); bf16_t* WIN = (bf16_t*)(ws + WS_WIN); bf16_t* WOUT = (bf16_t*)(ws + WS_WOUT);
        bf16_t* WLD = (bf16_t*)(ws + WS_WLD); bf16_t* WKVUP = (bf16_t*)(ws + WS_WKVUP); bf16_t* WQUP = (bf16_t*)(ws + WS_WQUP); bf16_t* BWO = (bf16_t*)(ws + WS_BWO);
        constexpr int NITEMS = 1536 + 512 + 2 * 2816 + 2 * 1408 + 128 + 16 + 192 + 128 + 128 + 192 + 96 + 512;
        for (int it = gw; it < NITEMS; it += NGW) {
            int r = it;
            if (r < 1536) { transpose_item(KIN(7), 1024, 3072, WQKV, 0, 0, nullptr, scr, r, lane); continue; } r -= 1536;
            if (r < 512) { transpose_item(KIN(8), 1024, 1024, WO, 0, 0, nullptr, scr, r, lane); continue; } r -= 512;
            if (r < 5632) { const int l = r / 2816; transpose_item(KIN(23) + (size_t)l * 1024 * FFN2, 1024, FFN2, WIN + (size_t)l * FFN2 * 1024, 1, 0, nullptr, scr, r % 2816, lane); continue; } r -= 5632;
            if (r < 2816) { const int l = r / 1408; transpose_item(KIN(26) + (size_t)l * FFN * 1024, FFN, 1024, WOUT + (size_t)l * 1024 * FFN, 0, 0, nullptr, scr, r % 1408, lane); continue; } r -= 2816;
            if (r < 128) { transpose_item(KIN(13), 1024, 256, WLD, 0, 0, nullptr, scr, r, lane); continue; } r -= 128;
            if (r < 16) { transpose_item(KIN(17), 1024, 32, WLD, 0, 256, nullptr, scr, r, lane); continue; } r -= 16;
            if (r < 192) { transpose_item(KIN(18), 1024, 384, WLD, 0, 512, nullptr, scr, r, lane); continue; } r -= 192;
            if (r < 128) { transpose_item(KIN(15), 256, 1024, WKVUP, 0, 0, KIN(14), scr, r, lane); continue; } r -= 128;
            if (r < 128) { transpose_item(KIN(16), 256, 1024, WKVUP, 0, 1024, KIN(14), scr, r, lane); continue; } r -= 128;
            if (r < 192) { transpose_item(KIN(20), 384, 1024, WQUP, 0, 0, KIN(19), scr, r, lane); continue; } r -= 192;
            if (r < 96) { transpose_item(KIN(21), 384, 512, WQUP, 0, 1024, KIN(19), scr, r, lane); continue; } r -= 96;
            transpose_item(KIN(22), 1024, 1024, BWO, 0, 0, nullptr, scr, r, lane);
        }
        const int gt = bx * 512 + tid, NGT = G * 512;
        for (int i = gt; i < 352 * 128; i += NGT) { const int rr = i >> 7, piece = i & 127; const int row = rr < 224 ? 288 + rr : 896 + (rr - 224);
            *(u32x4*)(WLD + (size_t)row * 1024 + piece * 8) = (u32x4){0u, 0u, 0u, 0u}; }
        const int* pos = (const int*)karg(2); float* cosT = (float*)(ws + WS_COS); float* sinT = (float*)(ws + WS_SIN);
        for (int i = gt; i < T * 16; i += NGT) { const int t = i >> 4, j = i & 15; const float ang = (float)pos[t] * INV_FREQ[j];
            const double rev = (double)ang * 0.15915494309189535; const float fr = (float)(rev - rint(rev));
            cosT[i] = __builtin_amdgcn_cosf(fr); sinT[i] = __builtin_amdgcn_sinf(fr); }
    }
}

__device__ __forceinline__ float row_rstd(const float* xrow, int lane, f32x4 (&v)[4]) {
    float s = 0.f;
#pragma unroll
    for (int j = 0; j < 4; ++j) { v[j] = ((const f32x4*)xrow)[64 * j + lane]; s += (v[j].x * v[j].x + v[j].y * v[j].y) + (v[j].z * v[j].z + v[j].w * v[j].w); }
    return __builtin_amdgcn_rsqf(wave_sum(s, lane) * (1.0f / DM) + EPS);
}
__device__ __forceinline__ void mod_store(const f32x4 (&v)[4], float rstd, const float* g, const float* sh, const float* sc, bf16_t* orow, int lane) {
#pragma unroll
    for (int j = 0; j < 4; ++j) { const f32x4 gg = ((const f32x4*)g)[64 * j + lane], ss = ((const f32x4*)sh)[64 * j + lane], cc = ((const f32x4*)sc)[64 * j + lane];
        const f32x4 y = (v[j] * rstd * gg) * (cc + 1.0f) + ss;
        u32x2 w; w.x = cvt_pk_bf16(y.x, y.y); w.y = cvt_pk_bf16(y.z, y.w); ((u32x2*)orow)[64 * j + lane] = w; }
}
#define XB_TMO      128
#define XB_XCNT(j)  (256  + 64 * (j))
#define XB_XSUB(j)  (1280 + 64 * (j))
#define XB_XGEN(j)  (2304 + 64 * (j))
#define XB_TOP      3328
#define XB_TOPGEN   3392
#define XCD_BAR_WORDS 3456
#define XB_SPIN_CAP (1u << 18)

__device__ __forceinline__ unsigned xb_ld(unsigned* p)              { return __hip_atomic_load(p, __ATOMIC_RELAXED, __HIP_MEMORY_SCOPE_AGENT); }
__device__ __forceinline__ unsigned xb_add(unsigned* p, unsigned v) { return __hip_atomic_fetch_add(p, v, __ATOMIC_RELAXED, __HIP_MEMORY_SCOPE_AGENT); }
__device__ __forceinline__ unsigned xb_xcc_id() { return (unsigned)__builtin_amdgcn_s_getreg((3 << 11) | 20) & 0xFu; }
#define XB_SPIN(cond, bar) do { unsigned _sp = 0; while (cond) { __builtin_amdgcn_s_sleep(1); \
    if ((++_sp & 255u) == 0u) { if (xb_ld(&(bar)[XB_TMO])) break; if (_sp > XB_SPIN_CAP) { atomicAdd(&(bar)[XB_TMO], 1u); break; } } } } while (0)

struct XcdBarrier {
    unsigned* bar; unsigned x;
    volatile LAS unsigned* st;
};

__device__ __forceinline__ XcdBarrier xcd_barrier_post(unsigned* bar, volatile LAS unsigned* st) {
    XcdBarrier b; b.bar = bar; b.x = (unsigned)__builtin_amdgcn_readfirstlane((int)xb_xcc_id()); b.st = st;
    if (threadIdx.x == 0) (void)xb_add(&bar[XB_XCNT(b.x)], 1u);
    return b;
}
__device__ __forceinline__ void xcd_barrier_complete(unsigned* bar, unsigned x, unsigned& nloc, unsigned& nx) {
    const unsigned G = gridDim.x * gridDim.y * gridDim.z;
    unsigned sum, cnt, mine, sp = 0u;
    for (;;) {
        sum = 0u; cnt = 0u; mine = 0u;
#pragma unroll
        for (unsigned j = 0; j < 16; ++j) { const unsigned c = xb_ld(&bar[XB_XCNT(j)]); sum += c; cnt += (c > 0u) ? 1u : 0u; mine = (j == x) ? c : mine; }
        if (sum == G) break;
        __builtin_amdgcn_s_sleep(1);
        if ((++sp & 255u) == 0u) { if (xb_ld(&bar[XB_TMO])) break; if (sp > XB_SPIN_CAP) { atomicAdd(&bar[XB_TMO], 1u); break; } }
    }
    nloc = mine > 0u ? mine : 1u; nx = cnt > 0u ? cnt : 1u;
}

__device__ __forceinline__ void xcd_barrier(const XcdBarrier& b) {
    asm volatile("s_waitcnt vmcnt(0)" ::: "memory");
    __syncthreads();
    if (threadIdx.x == 0) {
        unsigned* bar = b.bar;
        __builtin_amdgcn_s_waitcnt(0);
        unsigned nloc = b.st[0], nx = b.st[1];
        if (nloc == 0u) { xcd_barrier_complete(bar, b.x, nloc, nx); b.st[0] = nloc; b.st[1] = nx; }
        const unsigned old = xb_add(&bar[XB_XSUB(b.x)], 1u);
        const unsigned gen = old / nloc;
        if (old + 1u == (gen + 1u) * nloc) {
            __builtin_amdgcn_fence(__ATOMIC_RELEASE, "agent");
            asm volatile("s_waitcnt vmcnt(0)" ::: "memory");
            const unsigned og = xb_add(&bar[XB_TOP], 1u);
            const unsigned tg = og / nx;
            if (og + 1u == (tg + 1u) * nx) xb_add(&bar[XB_TOPGEN], 1u);
            else XB_SPIN(xb_ld(&bar[XB_TOPGEN]) == tg, bar);
            __builtin_amdgcn_fence(__ATOMIC_ACQUIRE, "agent");
            xb_add(&bar[XB_XGEN(b.x)], 1u);
            asm volatile("s_waitcnt vmcnt(0)" ::: "memory");
        } else {
            XB_SPIN(xb_ld(&bar[XB_XGEN(b.x)]) == gen, bar);
            __builtin_amdgcn_fence(__ATOMIC_ACQUIRE, "agent");
            asm volatile("s_waitcnt vmcnt(0)" ::: "memory");
        }
    }
    __syncthreads();
}

template <class Epi, class S_> __device__ __forceinline__ void run_gemm(LAS unsigned char* lds, int K, const S_& S, const Epi& E) { pg8::gemm_phase<Epi, S_, true, true>(lds, K, S, E); }

__global__ void __launch_bounds__(512) fwd_megakernel(Params P) {
    extern __shared__ __attribute__((aligned(16))) unsigned char lds_raw[];
    LAS unsigned char* lds = (LAS unsigned char*)lds_raw;
    cg::grid_group grid = cg::this_grid();
    const int wid = __builtin_amdgcn_readfirstlane((int)threadIdx.x >> 6);
#define OPAQUE_LANE() unsigned om_ = ~0u; asm volatile("" : "+s"(om_)); int lane = __builtin_amdgcn_mbcnt_hi(om_, __builtin_amdgcn_mbcnt_lo(om_, 0u)); asm volatile("" : "+v"(lane))
#define OPAQUE_GRID() int G = G0, bx = bx0, gw = gw0, NGW = NGW0; asm volatile("" : "+s"(G), "+s"(bx), "+s"(gw), "+s"(NGW))
    const int G0 = gridDim.x, bx0 = blockIdx.x;
    const int gw0 = bx0 * 8 + wid, NGW0 = G0 * 8;
#define MODV ((float*)KWS(WS_MODV))
#define BF(off) ((bf16_t*)KWS(off))

    if (threadIdx.x < 2) ((volatile LAS unsigned*)(lds + MISC_OFF))[threadIdx.x] = 0u;
    __syncthreads();
    const unsigned xcc_x = xcd_barrier_post((unsigned*)KWS(WS_BAR), (volatile LAS unsigned*)(lds + MISC_OFF)).x;
#define GRID_SYNC() do { XcdBarrier xb_; xb_.bar = (unsigned*)KWS(WS_BAR); unsigned xo_ = xcc_x; asm volatile("" : "+s"(xo_)); xb_.x = xo_; xb_.st = (volatile LAS unsigned*)(lds + MISC_OFF); xcd_barrier(xb_); } while (0)
    if (KIN(0) == nullptr) grid.sync();
    for (int rep = 0; rep < REP_P0; ++rep) { if (PH & 1) { OPAQUE_GRID(); (void)gw; (void)NGW; p0_prologue(lds, G, bx); } __syncthreads(); }
    GRID_SYNC();
    for (int rep = 0; rep < EXTRA_SYNCS; ++rep) GRID_SYNC();

#pragma unroll 1
    for (int l = 0; l < 2; ++l) {
        if (l == 0) {
            { OPAQUE_LANE(); OPAQUE_GRID(); (void)G; (void)bx; const float* x = KIN(0); const float* modl = MODV; bf16_t* HN = BF(WS_HN); const float* g = KIN(5);
              for (int rep = 0; rep < REP_NORM1; ++rep)
              for (int m = gw; m < T; m += NGW) { const int b = m / SEQ; f32x4 v[4]; const float rstd = row_rstd(x + (size_t)m * DM, lane, v);
                mod_store(v, rstd, g, modl + b * 6144, modl + b * 6144 + 1024, HN + (size_t)m * DM, lane); } }
            GRID_SYNC();
            if (PH & 2) { OPAQUE_GRID(); (void)gw; (void)NGW; pg8::Sched<0> S; S.init(64, 12, 1024, KWS(WS_HN), nullptr, KWS(WS_WQKV), G, bx);
              pg8::EpiBf16 E{BF(WS_R1), DM, DM, (size_t)16 * 1024 * 1024, QS_A};
              for (int rep = 0; rep < REP_QKV; ++rep) run_gemm(lds, 1024, S, E); }
            GRID_SYNC();
            if (PH & 4) { OPAQUE_GRID(); (void)gw; (void)NGW; const bf16_t* R1 = BF(WS_R1); const bf16_t* R2 = BF(WS_R2); const bf16_t* R3 = BF(WS_R3); const float* rb = KIN(9);
              for (int rep = 0; rep < REP_ATTA; ++rep)
              for (int u = bx; u < 1024; u += G) { const int qb = u & 31, bh = u >> 5;
                att::attn_unit<64, true, 1>(lds, bh >> 4, bh & 15, qb * 256, R1, nullptr, R2, nullptr, R3, BF(WS_HN), rb + (bh & 15) * 257); } }
        } else {
            { OPAQUE_LANE(); OPAQUE_GRID(); (void)G; (void)bx; const float* out = KOUT; const float* modl = MODV + 2 * 6144; const float* kvmod = MODV + 24576; bf16_t* HN = BF(WS_HN); bf16_t* HN1 = BF(WS_HN1);
              const float* gkv = KIN(12); const float* g1 = KIN(5) + DM;
              for (int m = gw; m < T; m += NGW) { const int b = m / SEQ; f32x4 v[4]; const float rstd = row_rstd(out + (size_t)m * DM, lane, v);
                mod_store(v, rstd, gkv, kvmod + b * 2048, kvmod + b * 2048 + 1024, HN + (size_t)m * DM, lane);
                mod_store(v, rstd, g1, modl + b * 6144, modl + b * 6144 + 1024, HN1 + (size_t)m * DM, lane); } }
            GRID_SYNC();
            if (PH & 8) { OPAQUE_GRID(); (void)gw; (void)NGW; pg8::Sched<2> S; S.init(64, 4, 1024, KWS(WS_HN), KWS(WS_HN1), KWS(WS_WLD), G, bx);
              pg8::EpiLatDown E{BF(WS_CKV), BF(WS_CQ), BF(WS_KR), (float*)KWS(WS_SSQKV), (float*)KWS(WS_SSQQ), (const float*)KWS(WS_COS), (const float*)KWS(WS_SIN)}; run_gemm(lds, 1024, S, E); }
            GRID_SYNC();
            if (PH & 16) { OPAQUE_GRID(); (void)gw; (void)NGW; pg8::Sched<0> S; S.init(64, 8, KVL, KWS(WS_CKV), nullptr, KWS(WS_WKVUP), G, bx);
              pg8::EpiLatUp<false> E{BF(WS_R2), BF(WS_R3), (const float*)KWS(WS_SSQKV), (const float*)KWS(WS_COS), (const float*)KWS(WS_SIN)}; run_gemm(lds, KVL, S, E); }
            if (PH & 32) { OPAQUE_GRID(); (void)gw; (void)NGW; pg8::Sched<0> S; S.init(64, 6, QL, KWS(WS_CQ), nullptr, KWS(WS_WQUP), G, bx);
              pg8::EpiLatUp<true> E{BF(WS_R1), BF(WS_R4), (const float*)KWS(WS_SSQQ), (const float*)KWS(WS_COS), (const float*)KWS(WS_SIN)}; run_gemm(lds, QL, S, E); }
            GRID_SYNC();
            if (PH & 64) { OPAQUE_GRID(); (void)gw; (void)NGW; const bf16_t* R1 = BF(WS_R1); const bf16_t* R2 = BF(WS_R2); const bf16_t* R3 = BF(WS_R3); const bf16_t* R4 = BF(WS_R4); const bf16_t* KR = BF(WS_KR);
              for (int rep = 0; rep < REP_MLA; ++rep)
              for (int v0 = bx; v0 < 256; v0 += G) { const int vcu = (G == 256) ? (v0 % 8) * 32 + v0 / 8 : v0; const int bh = vcu >> 3, s = vcu & 7;
#pragma unroll 1
                for (int i = 0; i < 2; ++i) { const int qb = (i == 0) ? s : 15 - s;
                    att::attn_unit<96, false, 2>(lds, bh >> 4, bh & 15, qb * 512, R1, R4, R2, KR, R3, BF(WS_HN), nullptr); } } }
        }
        GRID_SYNC();
        if (PH & 128) { OPAQUE_GRID(); (void)gw; (void)NGW; pg8::Sched<0> S; S.init(64, 4, 1024, KWS(WS_HN), nullptr, KWS(l == 0 ? WS_WO : WS_BWO), G, bx);
          pg8::EpiRes E{l == 0 ? KIN(0) : (const float*)KOUT, KOUT, MODV + (size_t)l * 2 * 6144 + 2048}; run_gemm(lds, 1024, S, E); }
        GRID_SYNC();
        { OPAQUE_LANE(); OPAQUE_GRID(); (void)G; (void)bx; const float* out = KOUT; const float* modl = MODV + (size_t)l * 2 * 6144; bf16_t* HN = BF(WS_HN); const float* g = KIN(6) + l * DM;
          for (int m = gw; m < T; m += NGW) { const int b = m / SEQ, s = m % SEQ; f32x4 v[4]; const float rstd = row_rstd(out + (size_t)m * DM, lane, v);
            mod_store(v, rstd, g, modl + b * 6144 + 3072, modl + b * 6144 + 4096, HN + ((size_t)b * PADROWS + 2 + s) * DM, lane); }
          if (gw < 4) { bf16_t* z = HN + ((size_t)(gw >> 1) * PADROWS + (gw & 1)) * DM;
#pragma unroll
            for (int j = 0; j < 4; ++j) ((u32x2*)z)[64 * j + lane] = (u32x2){0u, 0u}; } }
        GRID_SYNC();
        if (PH & 256) { OPAQUE_GRID(); (void)gw; (void)NGW; pg8::Sched<1> S; S.init(2 * FT, 22, 1024, KWS(WS_HN), nullptr, KWS(WS_WIN + (size_t)l * FFN2 * 1024 * 2), G, bx);
          pg8::EpiConv E{KIN(24) + (size_t)l * 3 * FFN2, KIN(25) + (size_t)l * FFN2, BF(WS_ACT)};
          for (int rep = 0; rep < REP_FFNIN; ++rep) run_gemm(lds, 1024, S, E); }
        GRID_SYNC();
        if (PH & 512) { OPAQUE_GRID(); (void)gw; (void)NGW; pg8::Sched<0> S; S.init(64, 4, FFN, KWS(WS_ACT), nullptr, KWS(WS_WOUT + (size_t)l * 1024 * FFN * 2), G, bx);
          pg8::EpiRes E{KOUT, KOUT, MODV + (size_t)l * 2 * 6144 + 5120}; run_gemm(lds, FFN, S, E); }
        GRID_SYNC();
    }
    { OPAQUE_LANE(); OPAQUE_GRID(); (void)G; (void)bx; float* out = KOUT; const f32x4* fg = (const f32x4*)karg(27);
      for (int m = gw; m < T; m += NGW) { f32x4 v[4]; const float rstd = row_rstd(out + (size_t)m * DM, lane, v);
#pragma unroll
        for (int j = 0; j < 4; ++j) { const f32x4 gg = fg[64 * j + lane]; ((f32x4*)(out + (size_t)m * DM))[64 * j + lane] = v[j] * rstd * gg; } } }
}

extern "C" void kernel_launch(void* const* d_in, const int* in_sizes, int n_in, void* d_out, int out_size, void* d_ws, size_t ws_size, hipStream_t stream) {
    static int grid_blocks = 0;
    if (grid_blocks == 0) {
        if (n_in != 28 || out_size != T * DM || ws_size < WS_END) { fprintf(stderr, "kernel_launch: unexpected problem (n_in %d out %d ws %zu)\n", n_in, out_size, ws_size); grid_blocks = -1; return; }
        int dev = 0, cus = 0, per_cu = 0;
        hipGetDevice(&dev); hipDeviceGetAttribute(&cus, hipDeviceAttributeMultiprocessorCount, dev);
        if (hipFuncSetAttribute((const void*)fwd_megakernel, hipFuncAttributeMaxDynamicSharedMemorySize, LDS_BYTES) != hipSuccess) { fprintf(stderr, "kernel_launch: hipFuncSetAttribute failed\n"); grid_blocks = -1; return; }
        if (hipOccupancyMaxActiveBlocksPerMultiprocessor(&per_cu, (const void*)fwd_megakernel, 512, LDS_BYTES) != hipSuccess || per_cu < 1) { fprintf(stderr, "kernel_launch: occupancy query says %d\n", per_cu); per_cu = 1; (void)hipGetLastError(); }
        grid_blocks = cus * per_cu;
        if (grid_blocks > 256) grid_blocks = 256;
    }
    if (grid_blocks < 0) return;
    if (hipMemsetAsync((char*)d_ws + WS_BAR, 0, XCD_BAR_WORDS * 4, stream) != hipSuccess) { fprintf(stderr, "kernel_launch: hipMemsetAsync failed\n"); return; }
    Params p{};
    for (int i = 0; i < 28; ++i) p.in[i] = d_in[i];
    p.out = (float*)d_out; p.ws = (unsigned char*)d_ws;
    void* args[] = {&p};
    hipError_t e = hipLaunchCooperativeKernel((const void*)fwd_megakernel, dim3(grid_blocks), dim3(512), args, LDS_BYTES, stream);
    if (e != hipSuccess) fprintf(stderr, "cooperative launch failed: %s (grid %d)\n", hipGetErrorString(e), grid_blocks);
}
```
